# Optimizing an MI355X kernel written in HIP

```python
import numpy as np
import jax, jax.numpy as jnp
from jax import lax

D_MODEL = 1024
BATCH = 2
SEQ = 8192
DEPTH = 2

HEAD_DIM = 64
GM_GROUPS = 4
GM_WIDTH = GM_GROUPS * HEAD_DIM
GM_CHUNK = 128
NSA_HEADS = 8
NSA_KV_GROUPS = 2
NSA_HPG = NSA_HEADS // NSA_KV_GROUPS
NSA_WIDTH = NSA_HEADS * HEAD_DIM
NSA_KV_WIDTH = NSA_KV_GROUPS * HEAD_DIM
CMP_BLOCK = 32
CMP_STRIDE = 16
CMP_HIDDEN = 128
SEL_BLOCK = 64
SEL_TOPK = 16
N_LOCAL_SEL = 2
WINDOW = 512
Q_BLOCK = 128
MEM_HEADS = 4
MEM_WIDTH = MEM_HEADS * HEAD_DIM
MEM_LEN = 256
MIX_WIDTH = GM_WIDTH + NSA_WIDTH + MEM_WIDTH
ROPE_THETA = 10000.0
LN_EPS = 1e-5
ALPHA = (2.0 * DEPTH) ** 0.25
BETA = (8.0 * DEPTH) ** -0.25
NEG_INF = -1e30
FORCE_SCORE = 1e4

IN_SPLITS = (GM_WIDTH, GM_WIDTH, GM_WIDTH,
             NSA_WIDTH,
             NSA_KV_WIDTH, NSA_KV_WIDTH,
             NSA_KV_WIDTH, NSA_KV_WIDTH,
             NSA_KV_WIDTH, NSA_KV_WIDTH,
             NSA_HEADS * 3,
             NSA_WIDTH,
             MEM_WIDTH, MEM_WIDTH)
IN_COLS = int(sum(IN_SPLITS))
SPLIT_POINTS = tuple(int(c) for c in np.cumsum(IN_SPLITS)[:-1])

kernel_name = 'hymba_gmlp_nsa_memory_deepnorm'


def layer_norm(x, g, b):
    xf = x.astype(jnp.float32)
    mu = jnp.mean(xf, axis=-1, keepdims=True)
    var = jnp.mean(jnp.square(xf - mu), axis=-1, keepdims=True)
    y = (xf - mu) * lax.rsqrt(var + LN_EPS)
    return (y * g.astype(jnp.float32) + b.astype(jnp.float32)).astype(x.dtype)


def rope(x, pos):
    half = x.shape[-1] // 2
    inv_freq = ROPE_THETA ** (-jnp.arange(half, dtype=jnp.float32) * 2.0 / x.shape[-1])
    ang = pos.astype(jnp.float32)[:, None] * inv_freq[None, :]
    cos = jnp.cos(ang)[:, None, :].astype(x.dtype)
    sin = jnp.sin(ang)[:, None, :].astype(x.dtype)
    x1, x2 = x[..., :half], x[..., half:]
    return jnp.concatenate([x1 * cos - x2 * sin, x2 * cos + x1 * sin], axis=-1)


def masked_softmax(s, mask):
    p = jax.nn.softmax(jnp.where(mask, s, NEG_INF), axis=-1)
    return p * mask.astype(jnp.float32)


def gmlp_mixer(u, v, z, ln_g, ln_b, ws, bs):
    B, S, _ = u.shape
    u = jax.nn.gelu(u, approximate=False)
    v = jax.nn.gelu(v, approximate=False).reshape(B, S, GM_GROUPS, HEAD_DIM)
    v = layer_norm(v, ln_g, ln_b)
    n_chunk = S // GM_CHUNK
    v = v.reshape(B, n_chunk, GM_CHUNK, GM_GROUPS, HEAD_DIM)
    causal = jnp.tril(jnp.ones((GM_CHUNK, GM_CHUNK), ws.dtype))
    s = jnp.einsum('gij,bnjgc->bnigc', ws * causal[None], v) + bs.T[:, :, None]
    s = s.reshape(B, S, GM_WIDTH)
    return u * s * jax.nn.silu(z)


def nsa_mixer(q, kc, vc, ks, vs, kw, vw, gate_logits, z,
              cmp_pos_k, cmp_k_w1, cmp_k_w2, cmp_pos_v, cmp_v_w1, cmp_v_w2):
    B, S, _ = q.shape
    G, Hg, dh = NSA_KV_GROUPS, NSA_HPG, HEAD_DIM
    dtype = q.dtype
    pos = jnp.arange(S)
    q = rope(q.reshape(B, S, NSA_HEADS, dh), pos)
    kc = rope(kc.reshape(B, S, G, dh), pos)
    ks = rope(ks.reshape(B, S, G, dh), pos)
    kw = rope(kw.reshape(B, S, G, dh), pos)
    vc = vc.reshape(B, S, G, dh)
    vs = vs.reshape(B, S, G, dh)
    vw = vw.reshape(B, S, G, dh)

    n_cmp = (S - CMP_BLOCK) // CMP_STRIDE + 1
    cidx = np.arange(n_cmp)[:, None] * CMP_STRIDE + np.arange(CMP_BLOCK)[None, :]

    def compress(t, pos_emb, w1, w2):
        blk = t[:, cidx] + pos_emb[None, None, :, None, :]
        blk = blk.transpose(0, 3, 1, 2, 4).reshape(B, G, n_cmp, CMP_BLOCK * dh)
        return jax.nn.gelu(blk @ w1) @ w2

    k_cmp = compress(kc, cmp_pos_k, cmp_k_w1, cmp_k_w2)
    v_cmp = compress(vc, cmp_pos_v, cmp_v_w1, cmp_v_w2)

    n_sel = S // SEL_BLOCK
    topk = min(SEL_TOPK, n_sel)
    k_sel = ks.transpose(0, 2, 1, 3).reshape(B, G, n_sel, SEL_BLOCK, dh)
    v_sel = vs.transpose(0, 2, 1, 3).reshape(B, G, n_sel, SEL_BLOCK, dh)
    c_start = np.arange(n_cmp) * CMP_STRIDE
    s_start = np.arange(n_sel) * SEL_BLOCK
    overlap = jnp.asarray(((c_start[:, None] < s_start[None, :] + SEL_BLOCK) &
                           (c_start[:, None] + CMP_BLOCK > s_start[None, :])).astype(np.float32))

    k_win = jnp.pad(kw.transpose(0, 2, 1, 3), ((0, 0), (0, 0), (WINDOW, 0), (0, 0)))
    v_win = jnp.pad(vw.transpose(0, 2, 1, 3), ((0, 0), (0, 0), (WINDOW, 0), (0, 0)))

    n_qb = S // Q_BLOCK
    q_blocks = q.reshape(B, n_qb, Q_BLOCK, G, Hg, dh).transpose(1, 0, 3, 4, 2, 5)
    scale = dh ** -0.5
    gather = jax.vmap(jax.vmap(lambda kb, ix: kb[ix]))

    def block_fn(args):
        qblk, bi = args
        t = bi * Q_BLOCK + jnp.arange(Q_BLOCK)
        s_c = jnp.einsum('bghqd,bgnd->bghqn', qblk, k_cmp).astype(jnp.float32) * scale
        cmask = (jnp.arange(n_cmp) * CMP_STRIDE + CMP_BLOCK - 1)[None, :] <= t[:, None]
        p_c = masked_softmax(s_c, cmask)
        o_c = jnp.einsum('bghqn,bgnd->bghqd', p_c.astype(dtype), v_cmp)
        imp = jnp.einsum('bghqn,nj->bgqj', p_c, overlap)
        blk = jnp.arange(n_sel)[None, :]
        t_blk = (t // SEL_BLOCK)[:, None]
        valid = blk <= t_blk
        forced = (blk == 0) | (valid & (blk > t_blk - N_LOCAL_SEL))
        imp = jnp.where(forced, FORCE_SCORE, jnp.where(valid, imp, -1.0))
        _, top_idx = lax.top_k(imp, topk)
        kg = gather(k_sel, top_idx)
        vg = gather(v_sel, top_idx)
        s_s = jnp.einsum('bghqd,bgqkld->bghqkl', qblk, kg).astype(jnp.float32) * scale
        key_pos = top_idx[..., None] * SEL_BLOCK + jnp.arange(SEL_BLOCK)
        smask = key_pos <= t[None, None, :, None, None]
        n_keys = topk * SEL_BLOCK
        p_s = masked_softmax(s_s.reshape(B, G, Hg, Q_BLOCK, n_keys),
                             smask.reshape(B, G, 1, Q_BLOCK, n_keys))
        o_s = jnp.einsum('bghqm,bgqmd->bghqd', p_s.astype(dtype),
                         vg.reshape(B, G, Q_BLOCK, n_keys, dh))
        start = bi * Q_BLOCK
        kwb = lax.dynamic_slice_in_dim(k_win, start, WINDOW + Q_BLOCK, axis=2)
        vwb = lax.dynamic_slice_in_dim(v_win, start, WINDOW + Q_BLOCK, axis=2)
        s_w = jnp.einsum('bghqd,bgmd->bghqm', qblk, kwb).astype(jnp.float32) * scale
        kpos = start - WINDOW + jnp.arange(WINDOW + Q_BLOCK)
        wmask = ((kpos[None, :] <= t[:, None]) & (kpos[None, :] > t[:, None] - WINDOW)
                 & (kpos[None, :] >= 0))
        p_w = masked_softmax(s_w, wmask)
        o_w = jnp.einsum('bghqm,bgmd->bghqd', p_w.astype(dtype), vwb)
        return jnp.stack([o_c, o_s, o_w], axis=-1)

    outs = lax.map(block_fn, (q_blocks, jnp.arange(n_qb)))
    outs = outs.transpose(1, 0, 4, 2, 3, 5, 6).reshape(B, S, NSA_HEADS, dh, 3)
    gates = jax.nn.sigmoid(gate_logits.astype(jnp.float32)).reshape(B, S, NSA_HEADS, 3)
    o = jnp.einsum('bshdc,bshc->bshd', outs, gates.astype(dtype)).reshape(B, S, NSA_WIDTH)
    return o * jax.nn.silu(z)


def memory_mixer(q, z, mem, w_mem_kv):
    B, S, _ = q.shape
    kv = (mem @ w_mem_kv).reshape(mem.shape[0], mem.shape[1], 2, MEM_HEADS, HEAD_DIM)
    k, v = kv[:, :, 0], kv[:, :, 1]
    q = q.reshape(B, S, MEM_HEADS, HEAD_DIM)
    s = jnp.einsum('bshd,bmhd->bhsm', q, k).astype(jnp.float32) * HEAD_DIM ** -0.5
    p = jax.nn.softmax(s, axis=-1)
    o = jnp.einsum('bhsm,bmhd->bshd', p.astype(q.dtype), v).reshape(B, S, MEM_WIDTH)
    return o * jax.nn.silu(z)


def hybrid_layer(x, mem, w_in, gm_ln_g, gm_ln_b, gm_ws, gm_bs,
                 cmp_pos_k, cmp_k_w1, cmp_k_w2, cmp_pos_v, cmp_v_w1, cmp_v_w2,
                 w_mem_kv, w_out, ln_g, ln_b):
    h = x @ w_in
    (gm_u, gm_v, gm_z, nq, nkc, nvc, nks, nvs, nkw, nvw, ngate, nz,
     mq, mz) = jnp.split(h, SPLIT_POINTS, axis=-1)
    y_gm = gmlp_mixer(gm_u, gm_v, gm_z, gm_ln_g, gm_ln_b, gm_ws, gm_bs)
    y_nsa = nsa_mixer(nq, nkc, nvc, nks, nvs, nkw, nvw, ngate, nz,
                      cmp_pos_k, cmp_k_w1, cmp_k_w2, cmp_pos_v, cmp_v_w1, cmp_v_w2)
    y_mem = memory_mixer(mq, mz, mem, w_mem_kv)
    y = jnp.concatenate([y_gm, y_nsa, y_mem], axis=-1) @ w_out
    return layer_norm(ALPHA * x + y, ln_g, ln_b)


def setup_inputs(seed: int = 0) -> dict:
    key = jax.random.key(seed)
    ks = jax.random.split(key, 20)
    f32 = jnp.float32
    nrm = lambda k, shape, s: jax.random.normal(k, shape, f32) * s
    L = DEPTH
    return {
        'x': nrm(ks[0], (BATCH, SEQ, D_MODEL), 1.0),
        'mem': nrm(ks[1], (BATCH, MEM_LEN, D_MODEL), 1.0),
        'w_in': nrm(ks[2], (L, D_MODEL, IN_COLS), D_MODEL ** -0.5),
        'gm_ln_g': 1.0 + nrm(ks[3], (L, GM_GROUPS, HEAD_DIM), 0.01),
        'gm_ln_b': nrm(ks[4], (L, GM_GROUPS, HEAD_DIM), 0.01),
        'gm_ws': nrm(ks[5], (L, GM_GROUPS, GM_CHUNK, GM_CHUNK), GM_CHUNK ** -0.5),
        'gm_bs': 1.0 + nrm(ks[6], (L, GM_GROUPS, GM_CHUNK), 0.1),
        'cmp_pos_k': nrm(ks[7], (L, CMP_BLOCK, HEAD_DIM), 0.1),
        'cmp_k_w1': nrm(ks[8], (L, CMP_BLOCK * HEAD_DIM, CMP_HIDDEN), (CMP_BLOCK * HEAD_DIM) ** -0.5),
        'cmp_k_w2': nrm(ks[9], (L, CMP_HIDDEN, HEAD_DIM), CMP_HIDDEN ** -0.5),
        'cmp_pos_v': nrm(ks[10], (L, CMP_BLOCK, HEAD_DIM), 0.1),
        'cmp_v_w1': nrm(ks[11], (L, CMP_BLOCK * HEAD_DIM, CMP_HIDDEN), (CMP_BLOCK * HEAD_DIM) ** -0.5),
        'cmp_v_w2': nrm(ks[12], (L, CMP_HIDDEN, HEAD_DIM), CMP_HIDDEN ** -0.5),
        'w_mem_kv': nrm(ks[13], (L, D_MODEL, 2 * MEM_WIDTH), D_MODEL ** -0.5),
        'w_out': nrm(ks[14], (L, MIX_WIDTH, D_MODEL), BETA * MIX_WIDTH ** -0.5),
        'ln_g': 1.0 + nrm(ks[15], (L, D_MODEL), 0.01),
        'ln_b': nrm(ks[16], (L, D_MODEL), 0.01),
    }


def reference(x, mem, w_in, gm_ln_g, gm_ln_b, gm_ws, gm_bs,
              cmp_pos_k, cmp_k_w1, cmp_k_w2, cmp_pos_v, cmp_v_w1, cmp_v_w2,
              w_mem_kv, w_out, ln_g, ln_b):
    for l in range(DEPTH):
        x = hybrid_layer(x, mem, w_in[l], gm_ln_g[l], gm_ln_b[l], gm_ws[l], gm_bs[l],
                         cmp_pos_k[l], cmp_k_w1[l], cmp_k_w2[l],
                         cmp_pos_v[l], cmp_v_w1[l], cmp_v_w2[l],
                         w_mem_kv[l], w_out[l], ln_g[l], ln_b[l])
    return x
```

```cpp
#include <hip/hip_runtime.h>
#include <stdint.h>
#include <math.h>

typedef unsigned short bf16_t;
typedef short bf16x8 __attribute__((ext_vector_type(8)));
typedef float f32x4 __attribute__((ext_vector_type(4)));

#define TOK 16384
#define SEQ 8192
#define DMODEL 1024
#define HP 3200
#define INCOLS 3096
#define ALPHA_F 1.41421356237309515f
#define LN_EPS_F 1e-5f

enum { C_U = 0, C_V = 256, C_Z = 512, C_Q = 768, C_KC = 1280, C_VC = 1408, C_KS = 1536, C_VS = 1664, C_KW = 1792, C_VW = 1920,
       C_NZ = 2048, C_MQ = 2560, C_MZ = 2816, C_GATE = 3072 };

constexpr size_t WS_H = 0;
constexpr size_t WS_XB = WS_H + (size_t)TOK * HP * 2;
constexpr size_t WS_NSA = WS_XB + (size_t)TOK * 1024 * 2;
constexpr size_t WS_MIX = WS_NSA + (size_t)TOK * 512 * 4;
constexpr size_t WS_WIN = WS_MIX + (size_t)TOK * 1024 * 2;
constexpr size_t WS_WOUT = WS_WIN + (size_t)2 * HP * 1024 * 2;
constexpr size_t WS_WMEM = WS_WOUT + (size_t)2 * 1024 * 1024 * 2;
constexpr size_t WS_MEMB = WS_WMEM + (size_t)2 * 512 * 1024 * 2;
constexpr size_t WS_MEMKV = WS_MEMB + (size_t)512 * 1024 * 2;
constexpr size_t WS_ROPE = WS_MEMKV + (size_t)2 * 512 * 512 * 2;
constexpr size_t WS_KCMP = WS_ROPE + (size_t)2 * 8192 * 32 * 4;
constexpr size_t WS_VCMP = WS_KCMP + (size_t)4 * 512 * 64 * 2;
constexpr size_t WS_SEL = WS_VCMP + (size_t)4 * 512 * 64 * 2;
constexpr size_t WS_END = WS_SEL + (size_t)4 * 8192 * 16 * 4;

__device__ __forceinline__ bf16_t f2bf(float f) {
    unsigned u = __float_as_uint(f);
    u += 0x7fffu + ((u >> 16) & 1u);
    return (bf16_t)(u >> 16);
}
__device__ __forceinline__ float bf2f(bf16_t h) { return __uint_as_float(((unsigned)h) << 16); }
__device__ __forceinline__ float wave_max(float v) {
#pragma unroll
    for (int o = 32; o > 0; o >>= 1) v = fmaxf(v, __shfl_xor(v, o));
    return v;
}
__device__ __forceinline__ float wave_sum(float v) {
#pragma unroll
    for (int o = 32; o > 0; o >>= 1) v += __shfl_xor(v, o);
    return v;
}
__device__ __forceinline__ int wave_min_i(int v) {
#pragma unroll
    for (int o = 32; o > 0; o >>= 1) { int t = __shfl_xor(v, o); v = t < v ? t : v; }
    return v;
}
__device__ __forceinline__ float gelu_erf(float x) { return 0.5f * x * (1.f + erff(x * 0.70710678118654752f)); }
__device__ __forceinline__ float gelu_tanh(float x) { return 0.5f * x * (1.f + tanhf(0.7978845608028654f * (x + 0.044715f * x * x * x))); }
__device__ __forceinline__ float sigmoidf(float x) { return 1.f / (1.f + expf(-x)); }
__device__ __forceinline__ float siluf(float x) { return x / (1.f + expf(-x)); }

__global__ void k_transpose(const float* W, int K, int N, bf16_t* WT, int mode) {
    __shared__ float t[32][33];
    const int p0 = blockIdx.x * 32, k0 = blockIdx.y * 32, tx = threadIdx.x, ty = threadIdx.y;
    const int p = p0 + tx;
    int c;
    if (mode == 0) c = p < N ? p : -1;
    else { if (p < 2048) c = p; else if (p < 3072) c = p + 24; else if (p < 3096) c = p - 1024; else c = -1; }
    for (int i = ty; i < 32; i += 8) t[i][tx] = (c >= 0) ? W[(size_t)(k0 + i) * N + c] : 0.f;
    __syncthreads();
    for (int i = ty; i < 32; i += 8) WT[(size_t)(p0 + i) * K + k0 + tx] = f2bf(t[tx][i]);
}
__global__ void k_cvt(const float* x, bf16_t* o, int n4) {
    int i = blockIdx.x * blockDim.x + threadIdx.x;
    if (i < n4) { float4 v = ((const float4*)x)[i]; uint2 r; r.x = f2bf(v.x) | ((unsigned)f2bf(v.y) << 16); r.y = f2bf(v.z) | ((unsigned)f2bf(v.w) << 16); ((uint2*)o)[i] = r; }
}
__global__ void k_rope(float* tab) {
    int i = blockIdx.x * blockDim.x + threadIdx.x;
    if (i < 8192 * 32) { int pos = i >> 5, f = i & 31; float inv = powf(10000.f, -(float)f * 2.0f / 64.0f); float a = (float)pos * inv; tab[i] = cosf(a); tab[8192 * 32 + i] = sinf(a); }
}

struct EpiArgs { bf16_t* H; const float* rope; const float* resid; float* out; bf16_t* obf; int ldo; };

template <int EPI>
__global__ __launch_bounds__(256) void k_gemm(const bf16_t* A, const bf16_t* Bt, int K, EpiArgs ea) {
    __shared__ __attribute__((aligned(16))) bf16_t As[128 * 40];
    __shared__ __attribute__((aligned(16))) bf16_t Bs[128 * 40];
    const int tid = threadIdx.x, lane = tid & 63, wid = tid >> 6, wr = wid >> 1, wc = wid & 1;
    const int m0 = blockIdx.y * 128, n0 = blockIdx.x * 128;
    f32x4 acc[4][4];
#pragma unroll
    for (int i = 0; i < 4; ++i)
#pragma unroll
        for (int j = 0; j < 4; ++j) acc[i][j] = (f32x4){0.f, 0.f, 0.f, 0.f};
    const int lr0 = tid >> 2, lk = (tid & 3) * 8;
    const bf16_t* ap = A + (size_t)(m0 + lr0) * K + lk;
    const bf16_t* bp = Bt + (size_t)(n0 + lr0) * K + lk;
    uint4 ra0 = *(const uint4*)ap, ra1 = *(const uint4*)(ap + (size_t)64 * K);
    uint4 rb0 = *(const uint4*)bp, rb1 = *(const uint4*)(bp + (size_t)64 * K);
    for (int k0 = 0; k0 < K; k0 += 32) {
        __syncthreads();
        *(uint4*)&As[lr0 * 40 + lk] = ra0; *(uint4*)&As[(lr0 + 64) * 40 + lk] = ra1;
        *(uint4*)&Bs[lr0 * 40 + lk] = rb0; *(uint4*)&Bs[(lr0 + 64) * 40 + lk] = rb1;
        __syncthreads();
        if (k0 + 32 < K) {
            ra0 = *(const uint4*)(ap + k0 + 32); ra1 = *(const uint4*)(ap + (size_t)64 * K + k0 + 32);
            rb0 = *(const uint4*)(bp + k0 + 32); rb1 = *(const uint4*)(bp + (size_t)64 * K + k0 + 32);
        }
        bf16x8 af[4], bfr[4];
#pragma unroll
        for (int i = 0; i < 4; ++i) {
            af[i] = *(const bf16x8*)&As[(wr * 64 + i * 16 + (lane & 15)) * 40 + (lane >> 4) * 8];
            bfr[i] = *(const bf16x8*)&Bs[(wc * 64 + i * 16 + (lane & 15)) * 40 + (lane >> 4) * 8];
        }
#pragma unroll
        for (int i = 0; i < 4; ++i)
#pragma unroll
            for (int j = 0; j < 4; ++j) acc[i][j] = __builtin_amdgcn_mfma_f32_16x16x32_bf16(bfr[j], af[i], acc[i][j], 0, 0, 0);
    }
    const int tk = lane & 15, nq = lane >> 4;
    const int cb = n0 + wc * 64;
    if (EPI == 0) {
        int type;
        if (cb < 512) type = 0; else if (cb < 768) type = 1; else if (cb < 1280) type = 2;
        else if (cb < 2048) type = ((((cb - 1280) >> 6) >> 1) & 1) ? 4 : 3;
        else if (cb < 2560) type = 1; else if (cb < 2816) type = 5; else if (cb < 3072) type = 1; else type = 6;
#pragma unroll
        for (int mt = 0; mt < 4; ++mt) {
            const int token = m0 + wr * 64 + mt * 16 + tk;
            f32x4 v[4];
#pragma unroll
            for (int nt = 0; nt < 4; ++nt) v[nt] = acc[mt][nt];
            if (type == 0) {
#pragma unroll
                for (int nt = 0; nt < 4; ++nt)
#pragma unroll
                    for (int r = 0; r < 4; ++r) v[nt][r] = gelu_erf(v[nt][r]);
            } else if (type == 1) {
#pragma unroll
                for (int nt = 0; nt < 4; ++nt)
#pragma unroll
                    for (int r = 0; r < 4; ++r) v[nt][r] = siluf(v[nt][r]);
            } else if (type == 2 || type == 3) {
                const int pos = token & (SEQ - 1);
                const float sc = (type == 2) ? 0.125f : 1.f;
#pragma unroll
                for (int nt = 0; nt < 2; ++nt) {
                    const f32x4 cs = *(const f32x4*)(ea.rope + pos * 32 + nt * 16 + nq * 4);
                    const f32x4 sn = *(const f32x4*)(ea.rope + 8192 * 32 + pos * 32 + nt * 16 + nq * 4);
#pragma unroll
                    for (int r = 0; r < 4; ++r) {
                        const float x1 = v[nt][r], x2 = v[nt + 2][r];
                        v[nt][r] = (x1 * cs[r] - x2 * sn[r]) * sc;
                        v[nt + 2][r] = (x2 * cs[r] + x1 * sn[r]) * sc;
                    }
                }
            } else if (type == 5) {
#pragma unroll
                for (int nt = 0; nt < 4; ++nt)
#pragma unroll
                    for (int r = 0; r < 4; ++r) v[nt][r] *= 0.125f;
            } else if (type == 6) {
#pragma unroll
                for (int nt = 0; nt < 4; ++nt)
#pragma unroll
                    for (int r = 0; r < 4; ++r) v[nt][r] = sigmoidf(v[nt][r]);
            }
#pragma unroll
            for (int nt = 0; nt < 4; ++nt) {
                uint2 w; w.x = f2bf(v[nt][0]) | ((unsigned)f2bf(v[nt][1]) << 16); w.y = f2bf(v[nt][2]) | ((unsigned)f2bf(v[nt][3]) << 16);
                *(uint2*)(ea.H + (size_t)token * HP + cb + nt * 16 + nq * 4) = w;
            }
        }
    } else if (EPI == 1) {
#pragma unroll
        for (int mt = 0; mt < 4; ++mt) {
            const int token = m0 + wr * 64 + mt * 16 + tk;
#pragma unroll
            for (int nt = 0; nt < 4; ++nt) {
                uint2 w; w.x = f2bf(acc[mt][nt][0]) | ((unsigned)f2bf(acc[mt][nt][1]) << 16); w.y = f2bf(acc[mt][nt][2]) | ((unsigned)f2bf(acc[mt][nt][3]) << 16);
                *(uint2*)(ea.obf + (size_t)token * ea.ldo + cb + nt * 16 + nq * 4) = w;
            }
        }
    } else {
#pragma unroll
        for (int mt = 0; mt < 4; ++mt) {
            const int token = m0 + wr * 64 + mt * 16 + tk;
#pragma unroll
            for (int nt = 0; nt < 4; ++nt) {
                const size_t off = (size_t)token * 1024 + cb + nt * 16 + nq * 4;
                const f32x4 rs = *(const f32x4*)(ea.resid + off);
                f32x4 o;
#pragma unroll
                for (int r = 0; r < 4; ++r) o[r] = ALPHA_F * rs[r] + acc[mt][nt][r];
                *(f32x4*)(ea.out + off) = o;
            }
        }
    }
}

__global__ __launch_bounds__(256) void k_ln(float* buf, const float* g, const float* b, bf16_t* xb) {
    const int lane = threadIdx.x & 63, row = blockIdx.x * 4 + (threadIdx.x >> 6);
    float4* x4 = (float4*)(buf + (size_t)row * 1024);
    float4 v[4]; float s = 0.f;
#pragma unroll
    for (int j = 0; j < 4; ++j) { v[j] = x4[lane + 64 * j]; s += (v[j].x + v[j].y) + (v[j].z + v[j].w); }
    const float mean = wave_sum(s) * (1.f / 1024.f);
    float q = 0.f;
#pragma unroll
    for (int j = 0; j < 4; ++j) { v[j].x -= mean; v[j].y -= mean; v[j].z -= mean; v[j].w -= mean; q += (v[j].x * v[j].x + v[j].y * v[j].y) + (v[j].z * v[j].z + v[j].w * v[j].w); }
    const float rstd = rsqrtf(wave_sum(q) * (1.f / 1024.f) + LN_EPS_F);
#pragma unroll
    for (int j = 0; j < 4; ++j) {
        const float4 gg = ((const float4*)g)[lane + 64 * j], bb = ((const float4*)b)[lane + 64 * j];
        float4 o; o.x = v[j].x * rstd * gg.x + bb.x; o.y = v[j].y * rstd * gg.y + bb.y; o.z = v[j].z * rstd * gg.z + bb.z; o.w = v[j].w * rstd * gg.w + bb.w;
        x4[lane + 64 * j] = o;
        if (xb) { uint2 r; r.x = f2bf(o.x) | ((unsigned)f2bf(o.y) << 16); r.y = f2bf(o.z) | ((unsigned)f2bf(o.w) << 16); ((uint2*)(xb + (size_t)row * 1024))[lane + 64 * j] = r; }
    }
}

__global__ __launch_bounds__(256) void k_gmlp(const bf16_t* H, const float* lng, const float* lnb, const float* ws, const float* bs, bf16_t* MIX) {
    __shared__ float vl[128][64];
    const int g = blockIdx.x & 3, ch = blockIdx.x >> 2;
    const int row0 = ch * 128;
    const int tid = threadIdx.x, lane = tid & 63, w = tid >> 6;
    for (int r = w * 32; r < w * 32 + 32; ++r) {
        const float v = bf2f(H[(size_t)(row0 + r) * HP + C_V + g * 64 + lane]);
        const float mean = wave_sum(v) * (1.f / 64.f);
        const float d = v - mean;
        const float var = wave_sum(d * d) * (1.f / 64.f);
        vl[r][lane] = d * rsqrtf(var + LN_EPS_F) * lng[g * 64 + lane] + lnb[g * 64 + lane];
    }
    __syncthreads();
    const int c = lane;
    for (int i = w; i < 128; i += 4) {
        const float* wrow = ws + (size_t)(g * 128 + i) * 128;
        float acc = 0.f;
        for (int j = 0; j <= i; ++j) acc += wrow[j] * vl[j][c];
        const float s = acc + bs[g * 128 + i];
        const size_t hro = (size_t)(row0 + i) * HP;
        const float u = bf2f(H[hro + C_U + g * 64 + c]), z = bf2f(H[hro + C_Z + g * 64 + c]);
        MIX[(size_t)(row0 + i) * 1024 + g * 64 + c] = f2bf(u * s * z);
    }
}

__global__ __launch_bounds__(128) void k_compress(const bf16_t* H, const float* posk, const float* w1k, const float* w2k,
                                                  const float* posv, const float* w1v, const float* w2v, bf16_t* KC, bf16_t* VC) {
    __shared__ float blk[80][64];
    __shared__ float pe[32][64];
    __shared__ float hid[4][128];
    const int ng = blockIdx.x, g = blockIdx.y, b = blockIdx.z >> 1, which = blockIdx.z & 1;
    const float* pos = which ? posv : posk; const float* w1 = which ? w1v : w1k; const float* w2 = which ? w2v : w2k;
    bf16_t* out = which ? VC : KC;
    const int col = (which ? C_VC : C_KC) + g * 64;
    const int n0 = ng * 4, tok0 = n0 * 16, tid = threadIdx.x;
    for (int e = tid; e < 80 * 64; e += 128) { const int r = e >> 6, d = e & 63, tok = tok0 + r; blk[r][d] = tok < SEQ ? bf2f(H[(size_t)(b * SEQ + tok) * HP + col + d]) : 0.f; }
    for (int e = tid; e < 32 * 64; e += 128) pe[e >> 6][e & 63] = pos[e];
    __syncthreads();
    float acc[4] = {0.f, 0.f, 0.f, 0.f};
    for (int l = 0; l < 32; ++l)
        for (int d = 0; d < 64; ++d) {
            const float wv = w1[(size_t)(l * 64 + d) * 128 + tid], p = pe[l][d];
#pragma unroll
            for (int r = 0; r < 4; ++r) acc[r] += (blk[16 * r + l][d] + p) * wv;
        }
#pragma unroll
    for (int r = 0; r < 4; ++r) hid[r][tid] = gelu_tanh(acc[r]);
    __syncthreads();
    for (int o = tid; o < 256; o += 128) {
        const int r = o >> 6, c = o & 63, n = n0 + r;
        if (n < 511) { float s = 0.f; for (int hh = 0; hh < 128; ++hh) s += hid[r][hh] * w2[hh * 64 + c]; out[((size_t)((b * 2 + g) * 512 + n)) * 64 + c] = f2bf(s); }
    }
}

__device__ __forceinline__ void load_row64(const bf16_t* p, float (&k)[64]) {
    const uint4* p4 = (const uint4*)p;
#pragma unroll
    for (int i = 0; i < 8; ++i) {
        const uint4 v = p4[i];
        k[8 * i + 0] = __uint_as_float(v.x << 16); k[8 * i + 1] = __uint_as_float(v.x & 0xffff0000u);
        k[8 * i + 2] = __uint_as_float(v.y << 16); k[8 * i + 3] = __uint_as_float(v.y & 0xffff0000u);
        k[8 * i + 4] = __uint_as_float(v.z << 16); k[8 * i + 5] = __uint_as_float(v.z & 0xffff0000u);
        k[8 * i + 6] = __uint_as_float(v.w << 16); k[8 * i + 7] = __uint_as_float(v.w & 0xffff0000u);
    }
}
#define WAVE_LDS_SYNC() do { asm volatile("s_waitcnt lgkmcnt(0)" ::: "memory"); __builtin_amdgcn_wave_barrier(); } while (0)

template <bool SHARED, class KF>
__device__ __forceinline__ void attn_scores(const KF& F, int nkeys, float* sc, const float* qs, int lane) {
    const int nk64 = (nkeys + 63) & ~63;
    for (int base = 0; base < nk64; base += 64) {
        const int idx = base + lane;
        float s[4] = {-INFINITY, -INFINITY, -INFINITY, -INFINITY};
        if (idx < nkeys && F.valid(idx)) {
            float k[64];
            if (SHARED) load_row64(F.krow(idx, 0), k);
#pragma unroll
            for (int h = 0; h < 4; ++h) {
                if (!SHARED) load_row64(F.krow(idx, h), k);
                float a = 0.f;
#pragma unroll
                for (int d4 = 0; d4 < 16; ++d4) { const float4 q = *(const float4*)&qs[h * 64 + d4 * 4]; a += q.x * k[4 * d4] + q.y * k[4 * d4 + 1] + q.z * k[4 * d4 + 2] + q.w * k[4 * d4 + 3]; }
                s[h] = a;
            }
        }
        *(float4*)&sc[idx * 4] = make_float4(s[0], s[1], s[2], s[3]);
    }
    WAVE_LDS_SYNC();
#pragma unroll
    for (int h = 0; h < 4; ++h) {
        float m = -INFINITY;
        for (int idx = lane; idx < nk64; idx += 64) m = fmaxf(m, sc[idx * 4 + h]);
        m = wave_max(m);
        float l = 0.f;
        for (int idx = lane; idx < nk64; idx += 64) { const float sv = sc[idx * 4 + h]; const float e = (sv == -INFINITY) ? 0.f : expf(sv - m); l += e; sc[idx * 4 + h] = e; }
        l = wave_sum(l);
        const float inv = l > 0.f ? 1.f / l : 0.f;
        for (int idx = lane; idx < nk64; idx += 64) sc[idx * 4 + h] *= inv;
    }
    WAVE_LDS_SYNC();
}
template <bool SHARED, class KF>
__device__ __forceinline__ void attn_pv(const KF& F, int nkeys, const float* sc, int lane, float (&o)[4]) {
    o[0] = o[1] = o[2] = o[3] = 0.f;
#pragma unroll 4
    for (int idx = 0; idx < nkeys; ++idx) {
        const float4 p = *(const float4*)&sc[idx * 4];
        if (SHARED) { const float v = bf2f(F.vrow(idx, 0)[lane]); o[0] += p.x * v; o[1] += p.y * v; o[2] += p.z * v; o[3] += p.w * v; }
        else { o[0] += p.x * bf2f(F.vrow(idx, 0)[lane]); o[1] += p.y * bf2f(F.vrow(idx, 1)[lane]); o[2] += p.z * bf2f(F.vrow(idx, 2)[lane]); o[3] += p.w * bf2f(F.vrow(idx, 3)[lane]); }
    }
}

struct KF_Window { const bf16_t* H; int b, g, t;
    __device__ __forceinline__ bool valid(int idx) const { return (t - 511 + idx) >= 0; }
    __device__ __forceinline__ const bf16_t* krow(int idx, int) const { int kp = t - 511 + idx; kp = kp < 0 ? 0 : kp; return H + (size_t)(b * SEQ + kp) * HP + C_KW + g * 64; }
    __device__ __forceinline__ const bf16_t* vrow(int idx, int) const { int kp = t - 511 + idx; kp = kp < 0 ? 0 : kp; return H + (size_t)(b * SEQ + kp) * HP + C_VW + g * 64; }
};
struct KF_Cmp { const bf16_t* KC; const bf16_t* VC; int bg;
    __device__ __forceinline__ bool valid(int) const { return true; }
    __device__ __forceinline__ const bf16_t* krow(int idx, int) const { return KC + (size_t)(bg * 512 + idx) * 64; }
    __device__ __forceinline__ const bf16_t* vrow(int idx, int) const { return VC + (size_t)(bg * 512 + idx) * 64; }
};
struct KF_Sel { const bf16_t* H; const int* selb; int b, g, t;
    __device__ __forceinline__ int pos(int idx) const { return selb[idx >> 6] * 64 + (idx & 63); }
    __device__ __forceinline__ bool valid(int idx) const { return pos(idx) <= t; }
    __device__ __forceinline__ const bf16_t* krow(int idx, int) const { return H + (size_t)(b * SEQ + pos(idx)) * HP + C_KS + g * 64; }
    __device__ __forceinline__ const bf16_t* vrow(int idx, int) const { return H + (size_t)(b * SEQ + pos(idx)) * HP + C_VS + g * 64; }
};
struct KF_Mem { const bf16_t* KV; int b;
    __device__ __forceinline__ bool valid(int) const { return true; }
    __device__ __forceinline__ const bf16_t* krow(int idx, int h) const { return KV + (size_t)(b * 256 + idx) * 512 + h * 64; }
    __device__ __forceinline__ const bf16_t* vrow(int idx, int h) const { return KV + (size_t)(b * 256 + idx) * 512 + 256 + h * 64; }
};

#define ATT_WAVES 2
struct AttLds { float sc[ATT_WAVES][1024 * 4]; float qs[ATT_WAVES][256]; int selb[ATT_WAVES][16]; };

template <int MODE>
__global__ __launch_bounds__(64 * ATT_WAVES) void k_attn(const bf16_t* H, const bf16_t* KC, const bf16_t* VC, const bf16_t* MEMKV, float* NSA, bf16_t* MIX, int* SEL) {
    __shared__ __attribute__((aligned(16))) AttLds L;
    const int lane = threadIdx.x & 63, w = threadIdx.x >> 6;
    const int item = blockIdx.x * ATT_WAVES + w;
    float* sc = L.sc[w]; float* qs = L.qs[w]; int* selb = L.selb[w];
    int row, g;
    if (MODE == 3) { row = item; g = 0; } else { row = item >> 1; g = item & 1; }
    const int b = row >> 13, t = row & (SEQ - 1);
    const size_t hro = (size_t)row * HP;
    {
        const int qc = (MODE == 3) ? C_MQ : (C_Q + g * 256);
        const uint2 v = *(const uint2*)(H + hro + qc + lane * 4);
        *(float4*)&qs[lane * 4] = make_float4(__uint_as_float(v.x << 16), __uint_as_float(v.x & 0xffff0000u), __uint_as_float(v.y << 16), __uint_as_float(v.y & 0xffff0000u));
    }
    float o[4];
    if (MODE == 0) {
        KF_Window F{H, b, g, t};
        WAVE_LDS_SYNC();
        attn_scores<true>(F, 512, sc, qs, lane);
        attn_pv<true>(F, 512, sc, lane, o);
#pragma unroll
        for (int h = 0; h < 4; ++h) { const int hh = g * 4 + h; const float gt = bf2f(H[hro + C_GATE + hh * 3 + 2]); NSA[(size_t)row * 512 + hh * 64 + lane] = o[h] * gt; }
    } else if (MODE == 1) {
        KF_Cmp F{KC, VC, b * 2 + g};
        const int nk = t >= 31 ? ((t - 31) >> 4) + 1 : 0;
        WAVE_LDS_SYNC();
        attn_scores<true>(F, nk, sc, qs, lane);
        const int tblk = t >> 6;
        float v[2];
#pragma unroll
        for (int u = 0; u < 2; ++u) {
            const int j = lane + 64 * u; float im = 0.f;
            for (int n = 4 * j - 1; n <= 4 * j + 3; ++n) if (n >= 0 && n < nk) { const float4 p = *(const float4*)&sc[n * 4]; im += (p.x + p.y) + (p.z + p.w); }
            const bool val = j <= tblk, forced = (j == 0) || (val && j > tblk - 2);
            v[u] = forced ? 1e4f : (val ? im : -1.f);
        }
        int* so = SEL + ((size_t)((b * 2 + g) * SEQ + t)) * 16;
        for (int k = 0; k < 16; ++k) {
            float bv; int bj;
            if (v[0] >= v[1]) { bv = v[0]; bj = lane; } else { bv = v[1]; bj = lane + 64; }
            const float mv = wave_max(bv);
            const int mj = wave_min_i((bv == mv) ? bj : 1000);
            if (lane == 0) so[k] = (mv >= 0.f) ? mj : -1;
            if (mj == lane) v[0] = -2.f; else if (mj == lane + 64) v[1] = -2.f;
        }
        attn_pv<true>(F, nk, sc, lane, o);
#pragma unroll
        for (int h = 0; h < 4; ++h) { const int hh = g * 4 + h; const float gt = bf2f(H[hro + C_GATE + hh * 3 + 0]); NSA[(size_t)row * 512 + hh * 64 + lane] += o[h] * gt; }
    } else if (MODE == 2) {
        const int* si = SEL + ((size_t)((b * 2 + g) * SEQ + t)) * 16;
        int cnt = 0;
        if (lane < 16) { const int s = si[lane]; selb[lane] = s < 0 ? 0 : s; }
        for (int k = 0; k < 16; ++k) cnt += (si[k] >= 0) ? 1 : 0;
        KF_Sel F{H, selb, b, g, t};
        WAVE_LDS_SYNC();
        attn_scores<true>(F, cnt * 64, sc, qs, lane);
        attn_pv<true>(F, cnt * 64, sc, lane, o);
#pragma unroll
        for (int h = 0; h < 4; ++h) {
            const int hh = g * 4 + h; const float gt = bf2f(H[hro + C_GATE + hh * 3 + 1]);
            const float z = bf2f(H[hro + C_NZ + hh * 64 + lane]);
            const float tot = NSA[(size_t)row * 512 + hh * 64 + lane] + o[h] * gt;
            MIX[(size_t)row * 1024 + 256 + hh * 64 + lane] = f2bf(tot * z);
        }
    } else {
        KF_Mem F{MEMKV, b};
        WAVE_LDS_SYNC();
        attn_scores<false>(F, 256, sc, qs, lane);
        attn_pv<false>(F, 256, sc, lane, o);
#pragma unroll
        for (int h = 0; h < 4; ++h) { const float z = bf2f(H[hro + C_MZ + h * 64 + lane]); MIX[(size_t)row * 1024 + 768 + h * 64 + lane] = f2bf(o[h] * z); }
    }
}

extern "C" void kernel_launch(void* const* d_in, const int* in_sizes, int n_in, void* d_out, int out_size, void* d_ws, size_t ws_size, hipStream_t stream) {
    const float* x = (const float*)d_in[0];
    const float* mem = (const float*)d_in[1];
    const float* w_in = (const float*)d_in[2];
    const float* gm_ln_g = (const float*)d_in[3];
    const float* gm_ln_b = (const float*)d_in[4];
    const float* gm_ws = (const float*)d_in[5];
    const float* gm_bs = (const float*)d_in[6];
    const float* cmp_pos_k = (const float*)d_in[7];
    const float* cmp_k_w1 = (const float*)d_in[8];
    const float* cmp_k_w2 = (const float*)d_in[9];
    const float* cmp_pos_v = (const float*)d_in[10];
    const float* cmp_v_w1 = (const float*)d_in[11];
    const float* cmp_v_w2 = (const float*)d_in[12];
    const float* w_mem_kv = (const float*)d_in[13];
    const float* w_out = (const float*)d_in[14];
    const float* ln_g = (const float*)d_in[15];
    const float* ln_b = (const float*)d_in[16];
    float* out = (float*)d_out;
    char* ws = (char*)d_ws;
    bf16_t* H = (bf16_t*)(ws + WS_H); bf16_t* XB = (bf16_t*)(ws + WS_XB); float* NSA = (float*)(ws + WS_NSA); bf16_t* MIX = (bf16_t*)(ws + WS_MIX);
    bf16_t* WIN = (bf16_t*)(ws + WS_WIN); bf16_t* WOUT = (bf16_t*)(ws + WS_WOUT); bf16_t* WMEM = (bf16_t*)(ws + WS_WMEM);
    bf16_t* MEMB = (bf16_t*)(ws + WS_MEMB); bf16_t* MEMKV = (bf16_t*)(ws + WS_MEMKV); float* ROPE = (float*)(ws + WS_ROPE);
    bf16_t* KC = (bf16_t*)(ws + WS_KCMP); bf16_t* VC = (bf16_t*)(ws + WS_VCMP); int* SEL = (int*)(ws + WS_SEL);
    if (ws_size < WS_END) return;

    for (int l = 0; l < 2; ++l) {
        k_transpose<<<dim3(HP / 32, 1024 / 32), dim3(32, 8), 0, stream>>>(w_in + (size_t)l * 1024 * INCOLS, 1024, INCOLS, WIN + (size_t)l * HP * 1024, 1);
        k_transpose<<<dim3(1024 / 32, 1024 / 32), dim3(32, 8), 0, stream>>>(w_out + (size_t)l * 1024 * 1024, 1024, 1024, WOUT + (size_t)l * 1024 * 1024, 0);
        k_transpose<<<dim3(512 / 32, 1024 / 32), dim3(32, 8), 0, stream>>>(w_mem_kv + (size_t)l * 1024 * 512, 1024, 512, WMEM + (size_t)l * 512 * 1024, 0);
    }
    k_cvt<<<(TOK * 1024 / 4 + 255) / 256, 256, 0, stream>>>(x, XB, TOK * 1024 / 4);
    k_cvt<<<(512 * 1024 / 4 + 255) / 256, 256, 0, stream>>>(mem, MEMB, 512 * 1024 / 4);
    k_rope<<<(8192 * 32 + 255) / 256, 256, 0, stream>>>(ROPE);
    for (int l = 0; l < 2; ++l) {
        EpiArgs e{}; e.obf = MEMKV + (size_t)l * 512 * 512; e.ldo = 512;
        k_gemm<1><<<dim3(512 / 128, 512 / 128), 256, 0, stream>>>(MEMB, WMEM + (size_t)l * 512 * 1024, 1024, e);
    }
    for (int l = 0; l < 2; ++l) {
        {   EpiArgs e{}; e.H = H; e.rope = ROPE;
            k_gemm<0><<<dim3(HP / 128, TOK / 128), 256, 0, stream>>>(XB, WIN + (size_t)l * HP * 1024, 1024, e); }
        k_gmlp<<<2 * 64 * 4, 256, 0, stream>>>(H, gm_ln_g + l * 256, gm_ln_b + l * 256, gm_ws + (size_t)l * 4 * 128 * 128, gm_bs + l * 4 * 128, MIX);
        k_compress<<<dim3(128, 2, 4), 128, 0, stream>>>(H, cmp_pos_k + l * 2048, cmp_k_w1 + (size_t)l * 2048 * 128, cmp_k_w2 + l * 128 * 64,
                                                         cmp_pos_v + l * 2048, cmp_v_w1 + (size_t)l * 2048 * 128, cmp_v_w2 + l * 128 * 64, KC, VC);
        const bf16_t* mkv = MEMKV + (size_t)l * 512 * 512;
        k_attn<0><<<TOK * 2 / ATT_WAVES, 64 * ATT_WAVES, 0, stream>>>(H, KC, VC, mkv, NSA, MIX, SEL);
        k_attn<3><<<TOK / ATT_WAVES, 64 * ATT_WAVES, 0, stream>>>(H, KC, VC, mkv, NSA, MIX, SEL);
        k_attn<1><<<TOK * 2 / ATT_WAVES, 64 * ATT_WAVES, 0, stream>>>(H, KC, VC, mkv, NSA, MIX, SEL);
        k_attn<2><<<TOK * 2 / ATT_WAVES, 64 * ATT_WAVES, 0, stream>>>(H, KC, VC, mkv, NSA, MIX, SEL);
        {   EpiArgs e{}; e.resid = (l == 0) ? x : out; e.out = out;
            k_gemm<2><<<dim3(1024 / 128, TOK / 128), 256, 0, stream>>>(MIX, WOUT + (size_t)l * 1024 * 1024, 1024, e); }
        k_ln<<<TOK / 4, 256, 0, stream>>>(out, ln_g + l * 1024, ln_b + l * 1024, (l == 0) ? XB : nullptr);
    }
}
```

```cpp
#include <hip/hip_runtime.h>
#include <hip/hip_cooperative_groups.h>
#include <stdint.h>
#include <math.h>
#include <cstdio>
namespace cg = cooperative_groups;

typedef unsigned short bf16_t;
typedef short bf16x8 __attribute__((ext_vector_type(8)));
typedef float f32x4 __attribute__((ext_vector_type(4)));

#define TOK 16384
#define SEQ 8192
#define DMODEL 1024
#define HP 3200
#define INCOLS 3096
#define ALPHA_F 1.41421356237309515f
#define LN_EPS_F 1e-5f
#define NTHREADS 512

enum { C_U = 0, C_V = 256, C_Z = 512, C_Q = 768, C_KC = 1280, C_VC = 1408, C_KS = 1536, C_VS = 1664, C_KW = 1792, C_VW = 1920,
       C_NZ = 2048, C_MQ = 2560, C_MZ = 2816, C_GATE = 3072 };

constexpr size_t WS_H = 0;
constexpr size_t WS_XB = WS_H + (size_t)TOK * HP * 2;
constexpr size_t WS_NSA = WS_XB + (size_t)TOK * 1024 * 2;
constexpr size_t WS_MIX = WS_NSA + (size_t)TOK * 512 * 4;
constexpr size_t WS_WIN = WS_MIX + (size_t)TOK * 1024 * 2;
constexpr size_t WS_WOUT = WS_WIN + (size_t)2 * HP * 1024 * 2;
constexpr size_t WS_WMEM = WS_WOUT + (size_t)2 * 1024 * 1024 * 2;
constexpr size_t WS_MEMB = WS_WMEM + (size_t)2 * 512 * 1024 * 2;
constexpr size_t WS_MEMKV = WS_MEMB + (size_t)512 * 1024 * 2;
constexpr size_t WS_ROPE = WS_MEMKV + (size_t)2 * 512 * 512 * 2;
constexpr size_t WS_KCMP = WS_ROPE + (size_t)2 * 8192 * 32 * 4;
constexpr size_t WS_VCMP = WS_KCMP + (size_t)4 * 512 * 64 * 2;
constexpr size_t WS_END = WS_VCMP + (size_t)4 * 512 * 64 * 2;

constexpr int LDS_BYTES = 143360;

__device__ __forceinline__ bf16_t f2bf(float f) {
    unsigned u = __float_as_uint(f);
    u += 0x7fffu + ((u >> 16) & 1u);
    return (bf16_t)(u >> 16);
}
__device__ __forceinline__ float bf2f(bf16_t h) { return __uint_as_float(((unsigned)h) << 16); }
__device__ __forceinline__ float wave_max(float v) {
#pragma unroll
    for (int o = 32; o > 0; o >>= 1) v = fmaxf(v, __shfl_xor(v, o));
    return v;
}
__device__ __forceinline__ float wave_sum(float v) {
#pragma unroll
    for (int o = 32; o > 0; o >>= 1) v += __shfl_xor(v, o);
    return v;
}
__device__ __forceinline__ int wave_min_i(int v) {
#pragma unroll
    for (int o = 32; o > 0; o >>= 1) { int t = __shfl_xor(v, o); v = t < v ? t : v; }
    return v;
}
__device__ __forceinline__ float gelu_erf(float x) { return 0.5f * x * (1.f + erff(x * 0.70710678118654752f)); }
__device__ __forceinline__ float gelu_tanh(float x) { return 0.5f * x * (1.f + tanhf(0.7978845608028654f * (x + 0.044715f * x * x * x))); }
__device__ __forceinline__ float sigmoidf(float x) { return 1.f / (1.f + expf(-x)); }
__device__ __forceinline__ float siluf(float x) { return x / (1.f + expf(-x)); }

struct Params {
    const float* x; const float* mem; const float* w_in; const float* gm_ln_g; const float* gm_ln_b; const float* gm_ws; const float* gm_bs;
    const float* cmp_pos_k; const float* cmp_k_w1; const float* cmp_k_w2; const float* cmp_pos_v; const float* cmp_v_w1; const float* cmp_v_w2;
    const float* w_mem_kv; const float* w_out; const float* ln_g; const float* ln_b;
    float* out; char* ws;
};

__device__ __forceinline__ void transpose_tile(const float* W, int K, int N, bf16_t* WT, int mode, int tp, int tk, float* t, int htid, bool active) {
    const int tx = htid & 31, ty = htid >> 5, p0 = tp * 32, k0 = tk * 32, p = p0 + tx;
    int c;
    if (mode == 0) c = p < N ? p : -1;
    else { if (p < 2048) c = p; else if (p < 3072) c = p + 24; else if (p < 3096) c = p - 1024; else c = -1; }
    if (active) for (int i = ty; i < 32; i += 8) t[i * 33 + tx] = (c >= 0) ? W[(size_t)(k0 + i) * N + c] : 0.f;
    __syncthreads();
    if (active) for (int i = ty; i < 32; i += 8) WT[(size_t)(p0 + i) * K + k0 + tx] = f2bf(t[tx * 33 + i]);
    __syncthreads();
}

struct EpiArgs { bf16_t* H; const float* rope; const float* resid; float* out; bf16_t* obf; int ldo; };

template <int EPI>
__device__ __forceinline__ void gemm_tile(const bf16_t* A, const bf16_t* Bt, int K, int m0, int n0, const EpiArgs& ea, bf16_t* As, bf16_t* Bs, int tid, bool active) {
    const int lane = tid & 63, wid = tid >> 6, wr = wid >> 1, wc = wid & 1;
    f32x4 acc[4][4];
#pragma unroll
    for (int i = 0; i < 4; ++i)
#pragma unroll
        for (int j = 0; j < 4; ++j) acc[i][j] = (f32x4){0.f, 0.f, 0.f, 0.f};
    const int lr0 = tid >> 2, lk = (tid & 3) * 8;
    const bf16_t* ap = A + (size_t)(m0 + lr0) * K + lk;
    const bf16_t* bp = Bt + (size_t)(n0 + lr0) * K + lk;
    uint4 ra0 = *(const uint4*)ap, ra1 = *(const uint4*)(ap + (size_t)64 * K);
    uint4 rb0 = *(const uint4*)bp, rb1 = *(const uint4*)(bp + (size_t)64 * K);
    for (int k0 = 0; k0 < K; k0 += 32) {
        __syncthreads();
        *(uint4*)&As[lr0 * 40 + lk] = ra0; *(uint4*)&As[(lr0 + 64) * 40 + lk] = ra1;
        *(uint4*)&Bs[lr0 * 40 + lk] = rb0; *(uint4*)&Bs[(lr0 + 64) * 40 + lk] = rb1;
        __syncthreads();
        if (k0 + 32 < K) {
            ra0 = *(const uint4*)(ap + k0 + 32); ra1 = *(const uint4*)(ap + (size_t)64 * K + k0 + 32);
            rb0 = *(const uint4*)(bp + k0 + 32); rb1 = *(const uint4*)(bp + (size_t)64 * K + k0 + 32);
        }
        bf16x8 af[4], bfr[4];
#pragma unroll
        for (int i = 0; i < 4; ++i) {
            af[i] = *(const bf16x8*)&As[(wr * 64 + i * 16 + (lane & 15)) * 40 + (lane >> 4) * 8];
            bfr[i] = *(const bf16x8*)&Bs[(wc * 64 + i * 16 + (lane & 15)) * 40 + (lane >> 4) * 8];
        }
#pragma unroll
        for (int i = 0; i < 4; ++i)
#pragma unroll
            for (int j = 0; j < 4; ++j) acc[i][j] = __builtin_amdgcn_mfma_f32_16x16x32_bf16(bfr[j], af[i], acc[i][j], 0, 0, 0);
    }
    if (!active) return;
    const int tk = lane & 15, nq = lane >> 4;
    const int cb = n0 + wc * 64;
    if (EPI == 0) {
        int type;
        if (cb < 512) type = 0; else if (cb < 768) type = 1; else if (cb < 1280) type = 2;
        else if (cb < 2048) type = ((((cb - 1280) >> 6) >> 1) & 1) ? 4 : 3;
        else if (cb < 2560) type = 1; else if (cb < 2816) type = 5; else if (cb < 3072) type = 1; else type = 6;
#pragma unroll
        for (int mt = 0; mt < 4; ++mt) {
            const int token = m0 + wr * 64 + mt * 16 + tk;
            f32x4 v[4];
#pragma unroll
            for (int nt = 0; nt < 4; ++nt) v[nt] = acc[mt][nt];
            if (type == 0) {
#pragma unroll
                for (int nt = 0; nt < 4; ++nt)
#pragma unroll
                    for (int r = 0; r < 4; ++r) v[nt][r] = gelu_erf(v[nt][r]);
            } else if (type == 1) {
#pragma unroll
                for (int nt = 0; nt < 4; ++nt)
#pragma unroll
                    for (int r = 0; r < 4; ++r) v[nt][r] = siluf(v[nt][r]);
            } else if (type == 2 || type == 3) {
                const int pos = token & (SEQ - 1);
                const float sc = (type == 2) ? 0.125f : 1.f;
#pragma unroll
                for (int nt = 0; nt < 2; ++nt) {
                    const f32x4 cs = *(const f32x4*)(ea.rope + pos * 32 + nt * 16 + nq * 4);
                    const f32x4 sn = *(const f32x4*)(ea.rope + 8192 * 32 + pos * 32 + nt * 16 + nq * 4);
#pragma unroll
                    for (int r = 0; r < 4; ++r) {
                        const float x1 = v[nt][r], x2 = v[nt + 2][r];
                        v[nt][r] = (x1 * cs[r] - x2 * sn[r]) * sc;
                        v[nt + 2][r] = (x2 * cs[r] + x1 * sn[r]) * sc;
                    }
                }
            } else if (type == 5) {
#pragma unroll
                for (int nt = 0; nt < 4; ++nt)
#pragma unroll
                    for (int r = 0; r < 4; ++r) v[nt][r] *= 0.125f;
            } else if (type == 6) {
#pragma unroll
                for (int nt = 0; nt < 4; ++nt)
#pragma unroll
                    for (int r = 0; r < 4; ++r) v[nt][r] = sigmoidf(v[nt][r]);
            }
#pragma unroll
            for (int nt = 0; nt < 4; ++nt) {
                uint2 w; w.x = f2bf(v[nt][0]) | ((unsigned)f2bf(v[nt][1]) << 16); w.y = f2bf(v[nt][2]) | ((unsigned)f2bf(v[nt][3]) << 16);
                *(uint2*)(ea.H + (size_t)token * HP + cb + nt * 16 + nq * 4) = w;
            }
        }
    } else if (EPI == 1) {
#pragma unroll
        for (int mt = 0; mt < 4; ++mt) {
            const int token = m0 + wr * 64 + mt * 16 + tk;
#pragma unroll
            for (int nt = 0; nt < 4; ++nt) {
                uint2 w; w.x = f2bf(acc[mt][nt][0]) | ((unsigned)f2bf(acc[mt][nt][1]) << 16); w.y = f2bf(acc[mt][nt][2]) | ((unsigned)f2bf(acc[mt][nt][3]) << 16);
                *(uint2*)(ea.obf + (size_t)token * ea.ldo + cb + nt * 16 + nq * 4) = w;
            }
        }
    } else {
#pragma unroll
        for (int mt = 0; mt < 4; ++mt) {
            const int token = m0 + wr * 64 + mt * 16 + tk;
#pragma unroll
            for (int nt = 0; nt < 4; ++nt) {
                const size_t off = (size_t)token * 1024 + cb + nt * 16 + nq * 4;
                const f32x4 rs = *(const f32x4*)(ea.resid + off);
                f32x4 o;
#pragma unroll
                for (int r = 0; r < 4; ++r) o[r] = ALPHA_F * rs[r] + acc[mt][nt][r];
                *(f32x4*)(ea.out + off) = o;
            }
        }
    }
}

template <int EPI>
__device__ __forceinline__ void gemm_phase(const bf16_t* A, const bf16_t* Bt, int K, int ntm, int ntn, const EpiArgs& ea, char* lds, int bid, int nb, int tid) {
    const int half = tid >> 8, htid = tid & 255;
    bf16_t* As = (bf16_t*)(lds + half * 20480); bf16_t* Bs = As + 128 * 40;
    const int nt = ntm * ntn;
    for (int t0 = bid * 2; t0 < nt; t0 += nb * 2) {
        const int t = t0 + half; const bool active = t < nt; const int tt = active ? t : nt - 1;
        gemm_tile<EPI>(A, Bt, K, (tt / ntn) * 128, (tt % ntn) * 128, ea, As, Bs, htid, active);
    }
    __syncthreads();
}

__device__ __forceinline__ void ln_row(float* buf, const float* g, const float* b, bf16_t* xb, int row, int lane) {
    float4* x4 = (float4*)(buf + (size_t)row * 1024);
    float4 v[4]; float s = 0.f;
#pragma unroll
    for (int j = 0; j < 4; ++j) { v[j] = x4[lane + 64 * j]; s += (v[j].x + v[j].y) + (v[j].z + v[j].w); }
    const float mean = wave_sum(s) * (1.f / 1024.f);
    float q = 0.f;
#pragma unroll
    for (int j = 0; j < 4; ++j) { v[j].x -= mean; v[j].y -= mean; v[j].z -= mean; v[j].w -= mean; q += (v[j].x * v[j].x + v[j].y * v[j].y) + (v[j].z * v[j].z + v[j].w * v[j].w); }
    const float rstd = rsqrtf(wave_sum(q) * (1.f / 1024.f) + LN_EPS_F);
#pragma unroll
    for (int j = 0; j < 4; ++j) {
        const float4 gg = ((const float4*)g)[lane + 64 * j], bb = ((const float4*)b)[lane + 64 * j];
        float4 o; o.x = v[j].x * rstd * gg.x + bb.x; o.y = v[j].y * rstd * gg.y + bb.y; o.z = v[j].z * rstd * gg.z + bb.z; o.w = v[j].w * rstd * gg.w + bb.w;
        x4[lane + 64 * j] = o;
        if (xb) { uint2 r; r.x = f2bf(o.x) | ((unsigned)f2bf(o.y) << 16); r.y = f2bf(o.z) | ((unsigned)f2bf(o.w) << 16); ((uint2*)(xb + (size_t)row * 1024))[lane + 64 * j] = r; }
    }
}

__device__ __forceinline__ void gmlp_unit(const bf16_t* H, const float* lng, const float* lnb, const float* ws, const float* bs, bf16_t* MIX, int unit, float* vl, int htid) {
    const int g = unit & 3, ch = unit >> 2;
    const int row0 = ch * 128;
    const int lane = htid & 63, w = htid >> 6;
    for (int r = w * 32; r < w * 32 + 32; ++r) {
        const float v = bf2f(H[(size_t)(row0 + r) * HP + C_V + g * 64 + lane]);
        const float mean = wave_sum(v) * (1.f / 64.f);
        const float d = v - mean;
        const float var = wave_sum(d * d) * (1.f / 64.f);
        vl[r * 64 + lane] = d * rsqrtf(var + LN_EPS_F) * lng[g * 64 + lane] + lnb[g * 64 + lane];
    }
    __syncthreads();
    const int c = lane;
    for (int i = w; i < 128; i += 4) {
        const float* wrow = ws + (size_t)(g * 128 + i) * 128;
        float acc = 0.f;
        for (int j = 0; j <= i; ++j) acc += wrow[j] * vl[j * 64 + c];
        const float s = acc + bs[g * 128 + i];
        const size_t hro = (size_t)(row0 + i) * HP;
        const float u = bf2f(H[hro + C_U + g * 64 + c]), z = bf2f(H[hro + C_Z + g * 64 + c]);
        MIX[(size_t)(row0 + i) * 1024 + g * 64 + c] = f2bf(u * s * z);
    }
    __syncthreads();
}

__device__ __forceinline__ void compress_unit(const bf16_t* H, const Params& p, int l, bf16_t* KC, bf16_t* VC, int unit, float* lq, int qtid) {
    float* blk = lq; float* pe = lq + 80 * 64; float* hid = pe + 32 * 64;
    const int ng = unit & 127, g = (unit >> 7) & 1, b = (unit >> 8) & 1, which = unit >> 9;
    const float* pos = (which ? p.cmp_pos_v : p.cmp_pos_k) + l * 2048;
    const float* w1 = (which ? p.cmp_v_w1 : p.cmp_k_w1) + (size_t)l * 2048 * 128;
    const float* w2 = (which ? p.cmp_v_w2 : p.cmp_k_w2) + l * 128 * 64;
    bf16_t* out = which ? VC : KC;
    const int col = (which ? C_VC : C_KC) + g * 64;
    const int n0 = ng * 4, tok0 = n0 * 16;
    for (int e = qtid; e < 80 * 64; e += 128) { const int r = e >> 6, d = e & 63, tok = tok0 + r; blk[e] = tok < SEQ ? bf2f(H[(size_t)(b * SEQ + tok) * HP + col + d]) : 0.f; }
    for (int e = qtid; e < 32 * 64; e += 128) pe[e] = pos[e];
    __syncthreads();
    float acc[4] = {0.f, 0.f, 0.f, 0.f};
    for (int l2 = 0; l2 < 32; ++l2)
        for (int d = 0; d < 64; ++d) {
            const float wv = w1[(size_t)(l2 * 64 + d) * 128 + qtid], pp = pe[l2 * 64 + d];
#pragma unroll
            for (int r = 0; r < 4; ++r) acc[r] += (blk[(16 * r + l2) * 64 + d] + pp) * wv;
        }
#pragma unroll
    for (int r = 0; r < 4; ++r) hid[r * 128 + qtid] = gelu_tanh(acc[r]);
    __syncthreads();
    for (int o = qtid; o < 256; o += 128) {
        const int r = o >> 6, c = o & 63, n = n0 + r;
        if (n < 511) { float s = 0.f; for (int hh = 0; hh < 128; ++hh) s += hid[r * 128 + hh] * w2[hh * 64 + c]; out[((size_t)((b * 2 + g) * 512 + n)) * 64 + c] = f2bf(s); }
    }
    __syncthreads();
}

#define WAVE_LDS_SYNC() do { asm volatile("s_waitcnt lgkmcnt(0)" ::: "memory"); __builtin_amdgcn_wave_barrier(); } while (0)

__device__ __forceinline__ void dot_row(const bf16_t* p, const float* qh, float& a) {
    const uint4* p4 = (const uint4*)p;
    uint4 kv[8];
#pragma unroll
    for (int i = 0; i < 8; ++i) kv[i] = p4[i];
#pragma unroll
    for (int i = 0; i < 8; ++i) {
        const float4 q0 = *(const float4*)&qh[i * 8], q1 = *(const float4*)&qh[i * 8 + 4];
        a += q0.x * __uint_as_float(kv[i].x << 16) + q0.y * __uint_as_float(kv[i].x & 0xffff0000u) + q0.z * __uint_as_float(kv[i].y << 16) + q0.w * __uint_as_float(kv[i].y & 0xffff0000u)
           + q1.x * __uint_as_float(kv[i].z << 16) + q1.y * __uint_as_float(kv[i].z & 0xffff0000u) + q1.z * __uint_as_float(kv[i].w << 16) + q1.w * __uint_as_float(kv[i].w & 0xffff0000u);
    }
}
__device__ __forceinline__ void dot_row4(const bf16_t* p, const float* qs, float (&s)[4]) {
    const uint4* p4 = (const uint4*)p;
    uint4 kv[8];
#pragma unroll
    for (int i = 0; i < 8; ++i) kv[i] = p4[i];
    s[0] = s[1] = s[2] = s[3] = 0.f;
#pragma unroll
    for (int i = 0; i < 8; ++i) {
        const float k0 = __uint_as_float(kv[i].x << 16), k1 = __uint_as_float(kv[i].x & 0xffff0000u), k2 = __uint_as_float(kv[i].y << 16), k3 = __uint_as_float(kv[i].y & 0xffff0000u);
        const float k4 = __uint_as_float(kv[i].z << 16), k5 = __uint_as_float(kv[i].z & 0xffff0000u), k6 = __uint_as_float(kv[i].w << 16), k7 = __uint_as_float(kv[i].w & 0xffff0000u);
#pragma unroll
        for (int h = 0; h < 4; ++h) {
            const float4 q0 = *(const float4*)&qs[h * 64 + i * 8], q1 = *(const float4*)&qs[h * 64 + i * 8 + 4];
            s[h] += q0.x * k0 + q0.y * k1 + q0.z * k2 + q0.w * k3 + q1.x * k4 + q1.y * k5 + q1.z * k6 + q1.w * k7;
        }
    }
}
template <bool SHARED, class KF>
__device__ __forceinline__ void attn_scores(const KF& F, int nkeys, float* sc, const float* qs, int lane) {
    const int nk64 = (nkeys + 63) & ~63;
    for (int base = 0; base < nk64; base += 64) {
        const int idx = base + lane;
        float s[4] = {-INFINITY, -INFINITY, -INFINITY, -INFINITY};
        if (idx < nkeys && F.valid(idx)) {
            if (SHARED) dot_row4(F.krow(idx, 0), qs, s);
            else {
#pragma unroll
                for (int h = 0; h < 4; ++h) { float a = 0.f; dot_row(F.krow(idx, h), qs + h * 64, a); s[h] = a; }
            }
        }
        *(float4*)&sc[idx * 4] = make_float4(s[0], s[1], s[2], s[3]);
    }
    WAVE_LDS_SYNC();
#pragma unroll
    for (int h = 0; h < 4; ++h) {
        float m = -INFINITY;
        for (int idx = lane; idx < nk64; idx += 64) m = fmaxf(m, sc[idx * 4 + h]);
        m = wave_max(m);
        float l = 0.f;
        for (int idx = lane; idx < nk64; idx += 64) { const float sv = sc[idx * 4 + h]; const float e = (sv == -INFINITY) ? 0.f : expf(sv - m); l += e; sc[idx * 4 + h] = e; }
        l = wave_sum(l);
        const float inv = l > 0.f ? 1.f / l : 0.f;
        for (int idx = lane; idx < nk64; idx += 64) sc[idx * 4 + h] *= inv;
    }
    WAVE_LDS_SYNC();
}
template <bool SHARED, class KF>
__device__ __forceinline__ void attn_pv(const KF& F, int nkeys, const float* sc, int lane, float (&o)[4]) {
    o[0] = o[1] = o[2] = o[3] = 0.f;
#pragma unroll 4
    for (int idx = 0; idx < nkeys; ++idx) {
        const float4 p = *(const float4*)&sc[idx * 4];
        if (SHARED) { const float v = bf2f(F.vrow(idx, 0)[lane]); o[0] += p.x * v; o[1] += p.y * v; o[2] += p.z * v; o[3] += p.w * v; }
        else { o[0] += p.x * bf2f(F.vrow(idx, 0)[lane]); o[1] += p.y * bf2f(F.vrow(idx, 1)[lane]); o[2] += p.z * bf2f(F.vrow(idx, 2)[lane]); o[3] += p.w * bf2f(F.vrow(idx, 3)[lane]); }
    }
}

struct KF_Window { const bf16_t* H; int b, g, t;
    __device__ __forceinline__ bool valid(int idx) const { return (t - 511 + idx) >= 0; }
    __device__ __forceinline__ const bf16_t* krow(int idx, int) const { int kp = t - 511 + idx; kp = kp < 0 ? 0 : kp; return H + (size_t)(b * SEQ + kp) * HP + C_KW + g * 64; }
    __device__ __forceinline__ const bf16_t* vrow(int idx, int) const { int kp = t - 511 + idx; kp = kp < 0 ? 0 : kp; return H + (size_t)(b * SEQ + kp) * HP + C_VW + g * 64; }
};
struct KF_Cmp { const bf16_t* KC; const bf16_t* VC; int bg;
    __device__ __forceinline__ bool valid(int) const { return true; }
    __device__ __forceinline__ const bf16_t* krow(int idx, int) const { return KC + (size_t)(bg * 512 + idx) * 64; }
    __device__ __forceinline__ const bf16_t* vrow(int idx, int) const { return VC + (size_t)(bg * 512 + idx) * 64; }
};
struct KF_Sel { const bf16_t* H; const int* selb; int b, g, t;
    __device__ __forceinline__ int pos(int idx) const { return selb[idx >> 6] * 64 + (idx & 63); }
    __device__ __forceinline__ bool valid(int idx) const { return pos(idx) <= t; }
    __device__ __forceinline__ const bf16_t* krow(int idx, int) const { return H + (size_t)(b * SEQ + pos(idx)) * HP + C_KS + g * 64; }
    __device__ __forceinline__ const bf16_t* vrow(int idx, int) const { return H + (size_t)(b * SEQ + pos(idx)) * HP + C_VS + g * 64; }
};
struct KF_Mem { const bf16_t* KV; int b;
    __device__ __forceinline__ bool valid(int) const { return true; }
    __device__ __forceinline__ const bf16_t* krow(int idx, int h) const { return KV + (size_t)(b * 256 + idx) * 512 + h * 64; }
    __device__ __forceinline__ const bf16_t* vrow(int idx, int h) const { return KV + (size_t)(b * 256 + idx) * 512 + 256 + h * 64; }
};

constexpr int ATT_WAVE_LDS = 1024 * 16 + 1024 + 64;

__device__ __forceinline__ void load_q(const bf16_t* H, size_t hro, int qc, float* qs, int lane) {
    const uint2 v = *(const uint2*)(H + hro + qc + lane * 4);
    *(float4*)&qs[lane * 4] = make_float4(__uint_as_float(v.x << 16), __uint_as_float(v.x & 0xffff0000u), __uint_as_float(v.y << 16), __uint_as_float(v.y & 0xffff0000u));
}

__device__ __forceinline__ void item_window(const bf16_t* H, float* NSA, int item, float* sc, float* qs, int lane) {
    const int row = item >> 1, g = item & 1, b = row >> 13, t = row & (SEQ - 1);
    const size_t hro = (size_t)row * HP;
    load_q(H, hro, C_Q + g * 256, qs, lane);
    KF_Window F{H, b, g, t};
    WAVE_LDS_SYNC();
    attn_scores<true>(F, 512, sc, qs, lane);
    float o[4];
    attn_pv<true>(F, 512, sc, lane, o);
#pragma unroll
    for (int h = 0; h < 4; ++h) { const int hh = g * 4 + h; const float gt = bf2f(H[hro + C_GATE + hh * 3 + 2]); NSA[(size_t)row * 512 + hh * 64 + lane] = o[h] * gt; }
    WAVE_LDS_SYNC();
}
__device__ __forceinline__ void item_mem(const bf16_t* H, const bf16_t* MEMKV, bf16_t* MIX, int item, float* sc, float* qs, int lane) {
    const int row = item, b = row >> 13;
    const size_t hro = (size_t)row * HP;
    load_q(H, hro, C_MQ, qs, lane);
    KF_Mem F{MEMKV, b};
    WAVE_LDS_SYNC();
    attn_scores<false>(F, 256, sc, qs, lane);
    float o[4];
    attn_pv<false>(F, 256, sc, lane, o);
#pragma unroll
    for (int h = 0; h < 4; ++h) { const float z = bf2f(H[hro + C_MZ + h * 64 + lane]); MIX[(size_t)row * 1024 + 768 + h * 64 + lane] = f2bf(o[h] * z); }
    WAVE_LDS_SYNC();
}
__device__ __forceinline__ void item_cmp_sel(const bf16_t* H, const bf16_t* KC, const bf16_t* VC, const float* NSA, bf16_t* MIX, int item, float* sc, float* qs, int* selb, int lane) {
    const int row = item >> 1, g = item & 1, b = row >> 13, t = row & (SEQ - 1);
    const size_t hro = (size_t)row * HP;
    load_q(H, hro, C_Q + g * 256, qs, lane);
    KF_Cmp F{KC, VC, b * 2 + g};
    const int nk = t >= 31 ? ((t - 31) >> 4) + 1 : 0;
    WAVE_LDS_SYNC();
    attn_scores<true>(F, nk, sc, qs, lane);
    const int tblk = t >> 6;
    float v[2];
#pragma unroll
    for (int u = 0; u < 2; ++u) {
        const int j = lane + 64 * u; float im = 0.f;
        for (int n = 4 * j - 1; n <= 4 * j + 3; ++n) if (n >= 0 && n < nk) { const float4 p = *(const float4*)&sc[n * 4]; im += (p.x + p.y) + (p.z + p.w); }
        const bool val = j <= tblk, forced = (j == 0) || (val && j > tblk - 2);
        v[u] = forced ? 1e4f : (val ? im : -1.f);
    }
    int cnt = 0;
    for (int k = 0; k < 16; ++k) {
        float bv; int bj;
        if (v[0] >= v[1]) { bv = v[0]; bj = lane; } else { bv = v[1]; bj = lane + 64; }
        const float mv = wave_max(bv);
        const int mj = wave_min_i((bv == mv) ? bj : 1000);
        if (mv >= 0.f) { if (lane == 0) selb[k] = mj; ++cnt; }
        if (mj == lane) v[0] = -2.f; else if (mj == lane + 64) v[1] = -2.f;
    }
    float oc[4];
    attn_pv<true>(F, nk, sc, lane, oc);
    WAVE_LDS_SYNC();
    KF_Sel G{H, selb, b, g, t};
    attn_scores<true>(G, cnt * 64, sc, qs, lane);
    float os[4];
    attn_pv<true>(G, cnt * 64, sc, lane, os);
#pragma unroll
    for (int h = 0; h < 4; ++h) {
        const int hh = g * 4 + h;
        const float gc = bf2f(H[hro + C_GATE + hh * 3 + 0]), gs = bf2f(H[hro + C_GATE + hh * 3 + 1]);
        const float z = bf2f(H[hro + C_NZ + hh * 64 + lane]);
        const float tot = NSA[(size_t)row * 512 + hh * 64 + lane] + oc[h] * gc + os[h] * gs;
        MIX[(size_t)row * 1024 + 256 + hh * 64 + lane] = f2bf(tot * z);
    }
    WAVE_LDS_SYNC();
}

#define FRESH_TID() int tid = threadIdx.x; asm volatile("" : "+v"(tid)); const int lane = tid & 63, wave = tid >> 6; (void)lane; (void)wave
__global__ __launch_bounds__(NTHREADS) void mega(Params p) {
    extern __shared__ __attribute__((aligned(16))) char lds[];
    cg::grid_group grid = cg::this_grid();
    const int bid = blockIdx.x, nb = gridDim.x;
    char* ws = p.ws;
    bf16_t* H = (bf16_t*)(ws + WS_H); bf16_t* XB = (bf16_t*)(ws + WS_XB); float* NSA = (float*)(ws + WS_NSA); bf16_t* MIX = (bf16_t*)(ws + WS_MIX);
    bf16_t* WIN = (bf16_t*)(ws + WS_WIN); bf16_t* WOUT = (bf16_t*)(ws + WS_WOUT); bf16_t* WMEM = (bf16_t*)(ws + WS_WMEM);
    bf16_t* MEMB = (bf16_t*)(ws + WS_MEMB); bf16_t* MEMKV = (bf16_t*)(ws + WS_MEMKV); float* ROPE = (float*)(ws + WS_ROPE);
    bf16_t* KC = (bf16_t*)(ws + WS_KCMP); bf16_t* VC = (bf16_t*)(ws + WS_VCMP);

    {
        FRESH_TID();
        const int half = tid >> 8, htid = tid & 255;
        float* tl = (float*)(lds + half * 4352);
        constexpr int U_IN = 100 * 32, U_OUT = 32 * 32, U_MEM = 16 * 32, U_L = U_IN + U_OUT + U_MEM, U_ALL = 2 * U_L;
        for (int u0 = bid * 2; u0 < U_ALL; u0 += nb * 2) {
            const int u = u0 + half; const bool active = u < U_ALL; const int uu = active ? u : U_ALL - 1;
            const int l = uu / U_L; int r = uu % U_L;
            if (r < U_IN) transpose_tile(p.w_in + (size_t)l * 1024 * INCOLS, 1024, INCOLS, WIN + (size_t)l * HP * 1024, 1, r >> 5, r & 31, tl, htid, active);
            else if (r < U_IN + U_OUT) { r -= U_IN; transpose_tile(p.w_out + (size_t)l * 1024 * 1024, 1024, 1024, WOUT + (size_t)l * 1024 * 1024, 0, r >> 5, r & 31, tl, htid, active); }
            else { r -= U_IN + U_OUT; transpose_tile(p.w_mem_kv + (size_t)l * 1024 * 512, 1024, 512, WMEM + (size_t)l * 512 * 1024, 0, r >> 5, r & 31, tl, htid, active); }
        }
        const int gt = bid * NTHREADS + tid, gs = nb * NTHREADS;
        for (int i = gt; i < TOK * 1024 / 4; i += gs) { const float4 v = ((const float4*)p.x)[i]; uint2 r; r.x = f2bf(v.x) | ((unsigned)f2bf(v.y) << 16); r.y = f2bf(v.z) | ((unsigned)f2bf(v.w) << 16); ((uint2*)XB)[i] = r; }
        for (int i = gt; i < 512 * 1024 / 4; i += gs) { const float4 v = ((const float4*)p.mem)[i]; uint2 r; r.x = f2bf(v.x) | ((unsigned)f2bf(v.y) << 16); r.y = f2bf(v.z) | ((unsigned)f2bf(v.w) << 16); ((uint2*)MEMB)[i] = r; }
        for (int i = gt; i < 8192 * 32; i += gs) { const int pos = i >> 5, f = i & 31; const float inv = powf(10000.f, -(float)f * 2.0f / 64.0f); const float a = (float)pos * inv; ROPE[i] = cosf(a); ROPE[8192 * 32 + i] = sinf(a); }
    }
    grid.sync();
    for (int l = 0; l < 2; ++l) { FRESH_TID(); EpiArgs e{}; e.obf = MEMKV + (size_t)l * 512 * 512; e.ldo = 512; gemm_phase<1>(MEMB, WMEM + (size_t)l * 512 * 1024, 1024, 4, 4, e, lds, bid, nb, tid); }

    for (int l = 0; l < 2; ++l) {
        { FRESH_TID(); EpiArgs e{}; e.H = H; e.rope = ROPE; gemm_phase<0>(XB, WIN + (size_t)l * HP * 1024, 1024, TOK / 128, HP / 128, e, lds, bid, nb, tid); }
        grid.sync();
        {
            FRESH_TID();
            const int q = tid >> 7, qtid = tid & 127;
            for (int u0 = bid * 4; u0 < 2048; u0 += nb * 4) compress_unit(H, p, l, KC, VC, u0 + q, (float*)(lds + q * 30720), qtid);
        }
        {
            FRESH_TID();
            const int half = tid >> 8, htid = tid & 255;
            for (int u0 = bid * 2; u0 < 512; u0 += nb * 2) gmlp_unit(H, p.gm_ln_g + l * 256, p.gm_ln_b + l * 256, p.gm_ws + (size_t)l * 4 * 128 * 128, p.gm_bs + l * 512, MIX, u0 + half, (float*)(lds + half * 32768), htid);
        }
        {
            FRESH_TID();
            float* sc = (float*)(lds + wave * ATT_WAVE_LDS); float* qs = sc + 4096;
            for (int it = bid * 8 + wave; it < TOK * 2; it += nb * 8) item_window(H, NSA, it, sc, qs, lane);
        }
        {
            FRESH_TID();
            float* sc = (float*)(lds + wave * ATT_WAVE_LDS); float* qs = sc + 4096;
            const bf16_t* mkv = MEMKV + (size_t)l * 512 * 512;
            for (int it = bid * 8 + wave; it < TOK; it += nb * 8) item_mem(H, mkv, MIX, it, sc, qs, lane);
        }
        grid.sync();
        {
            FRESH_TID();
            float* sc = (float*)(lds + wave * ATT_WAVE_LDS); float* qs = sc + 4096; int* selb = (int*)(qs + 256);
            for (int it = bid * 8 + wave; it < TOK * 2; it += nb * 8) item_cmp_sel(H, KC, VC, NSA, MIX, it, sc, qs, selb, lane);
        }
        grid.sync();
        { FRESH_TID(); EpiArgs e{}; e.resid = (l == 0) ? p.x : p.out; e.out = p.out; gemm_phase<2>(MIX, WOUT + (size_t)l * 1024 * 1024, 1024, TOK / 128, 8, e, lds, bid, nb, tid); }
        grid.sync();
        { FRESH_TID(); for (int row = bid * 8 + wave; row < TOK; row += nb * 8) ln_row(p.out, p.ln_g + l * 1024, p.ln_b + l * 1024, (l == 0) ? XB : nullptr, row, lane); }
        if (l == 0) grid.sync();
    }
}

extern "C" void kernel_launch(void* const* d_in, const int* in_sizes, int n_in, void* d_out, int out_size, void* d_ws, size_t ws_size, hipStream_t stream) {
    static int grid_blocks = 0;
    if (grid_blocks == 0) {
        int dev = 0, cus = 0, per_cu = 0;
        hipGetDevice(&dev);
        hipDeviceGetAttribute(&cus, hipDeviceAttributeMultiprocessorCount, dev);
        hipFuncSetAttribute((const void*)mega, hipFuncAttributeMaxDynamicSharedMemorySize, LDS_BYTES);
        hipOccupancyMaxActiveBlocksPerMultiprocessor(&per_cu, (const void*)mega, NTHREADS, LDS_BYTES);
        if (per_cu < 1) { fprintf(stderr, "occupancy query says %d blocks/CU\n", per_cu); per_cu = 1; }
        if (per_cu > 1) per_cu = 1;
        grid_blocks = cus * per_cu;
    }
    if (ws_size < WS_END || n_in < 17) return;
    Params p{};
    p.x = (const float*)d_in[0]; p.mem = (const float*)d_in[1]; p.w_in = (const float*)d_in[2]; p.gm_ln_g = (const float*)d_in[3]; p.gm_ln_b = (const float*)d_in[4];
    p.gm_ws = (const float*)d_in[5]; p.gm_bs = (const float*)d_in[6]; p.cmp_pos_k = (const float*)d_in[7]; p.cmp_k_w1 = (const float*)d_in[8]; p.cmp_k_w2 = (const float*)d_in[9];
    p.cmp_pos_v = (const float*)d_in[10]; p.cmp_v_w1 = (const float*)d_in[11]; p.cmp_v_w2 = (const float*)d_in[12]; p.w_mem_kv = (const float*)d_in[13]; p.w_out = (const float*)d_in[14];
    p.ln_g = (const float*)d_in[15]; p.ln_b = (const float*)d_in[16]; p.out = (float*)d_out; p.ws = (char*)d_ws;
    void* args[] = {&p};
    hipError_t e = hipLaunchCooperativeKernel((const void*)mega, dim3(grid_blocks), dim3(NTHREADS), args, LDS_BYTES, stream);
    if (e != hipSuccess) fprintf(stderr, "cooperative launch failed: %s (grid %d)\n", hipGetErrorString(e), grid_blocks);
}
```

```cpp
#include <hip/hip_runtime.h>
#include <hip/hip_cooperative_groups.h>
#include <stdint.h>
#include <math.h>
#include <cstdio>
namespace cg = cooperative_groups;

typedef unsigned short bf16_t;
typedef short bf16x8 __attribute__((ext_vector_type(8)));
typedef float f32x4 __attribute__((ext_vector_type(4)));

#define TOK 16384
#define SEQ 8192
#define DMODEL 1024
#define HP 3200
#define INCOLS 3096
#define ALPHA_F 1.41421356237309515f
#define LN_EPS_F 1e-5f
#define NTHREADS 512

enum { C_U = 0, C_V = 256, C_Z = 512, C_NZ = 768, C_MZ = 1280, C_GATE = 1536 };
#define HP2 1600
#define LOG2E_F 1.4426950408889634f
typedef float f32x16 __attribute__((ext_vector_type(16)));
typedef float f32x2_t __attribute__((ext_vector_type(2)));
typedef __bf16 bf16x2_t __attribute__((ext_vector_type(2)));

constexpr size_t MB16 = (size_t)TOK * 512 * 2;
constexpr size_t WS_H = 0;
constexpr size_t WS_XB = WS_H + (size_t)TOK * HP2 * 2;
constexpr size_t WS_QN = WS_XB + (size_t)TOK * 1024 * 2;
constexpr size_t WS_MQ = WS_QN + MB16;
constexpr size_t WS_KCR = WS_MQ + MB16 / 2;
constexpr size_t WS_VCR = WS_KCR + (size_t)4 * SEQ * 64 * 2;
constexpr size_t WS_KS = WS_VCR + (size_t)4 * SEQ * 64 * 2;
constexpr size_t WS_VST = WS_KS + (size_t)4 * SEQ * 64 * 2;
constexpr size_t WS_KW = WS_VST + (size_t)4 * SEQ * 64 * 2;
constexpr size_t WS_VWT = WS_KW + (size_t)4 * SEQ * 64 * 2;
constexpr size_t WS_OW = WS_VWT + (size_t)4 * SEQ * 64 * 2;
constexpr size_t WS_OC = WS_OW + MB16;
constexpr size_t WS_MIX = WS_OC + MB16;
constexpr size_t WS_WIN = WS_MIX + (size_t)TOK * 1024 * 2;
constexpr size_t WS_WOUT = WS_WIN + (size_t)2 * HP * 1024 * 2;
constexpr size_t WS_WMEM = WS_WOUT + (size_t)2 * 1024 * 1024 * 2;
constexpr size_t WS_MEMB = WS_WMEM + (size_t)2 * 512 * 1024 * 2;
constexpr size_t WS_MK = WS_MEMB + (size_t)512 * 1024 * 2;
constexpr size_t WS_MVT = WS_MK + (size_t)2 * 8 * 256 * 64 * 2;
constexpr size_t WS_ROPE = WS_MVT + (size_t)2 * 8 * 256 * 64 * 2;
constexpr size_t WS_KCMP = WS_ROPE + (size_t)2 * 8192 * 32 * 4;
constexpr size_t WS_VCMPT = WS_KCMP + (size_t)4 * 512 * 64 * 2;
constexpr size_t WS_SELM = WS_VCMPT + (size_t)4 * 512 * 64 * 2;
constexpr size_t WS_END = WS_SELM + (size_t)4 * SEQ * 4 * 4;
static_assert(WS_END <= (size_t)256 * 1024 * 1024, "workspace");

constexpr int LDS_BYTES = 143360;

__device__ __forceinline__ bf16_t f2bf(float f) {
    unsigned u = __float_as_uint(f);
    u += 0x7fffu + ((u >> 16) & 1u);
    return (bf16_t)(u >> 16);
}
__device__ __forceinline__ float bf2f(bf16_t h) { return __uint_as_float(((unsigned)h) << 16); }
__device__ __forceinline__ unsigned cvtpk(float lo, float hi) { f32x2_t v = {lo, hi}; bf16x2_t b = __builtin_convertvector(v, bf16x2_t); return __builtin_bit_cast(unsigned, b); }
__device__ __forceinline__ int crow(int r, int hi) { return (r & 3) + 8 * (r >> 2) + 4 * hi; }
__device__ __forceinline__ float wave_max(float v) {
#pragma unroll
    for (int o = 32; o > 0; o >>= 1) v = fmaxf(v, __shfl_xor(v, o));
    return v;
}
__device__ __forceinline__ float wave_sum(float v) {
#pragma unroll
    for (int o = 32; o > 0; o >>= 1) v += __shfl_xor(v, o);
    return v;
}
__device__ __forceinline__ int wave_min_i(int v) {
#pragma unroll
    for (int o = 32; o > 0; o >>= 1) { int t = __shfl_xor(v, o); v = t < v ? t : v; }
    return v;
}
__device__ __forceinline__ float gelu_erf(float x) { return 0.5f * x * (1.f + erff(x * 0.70710678118654752f)); }
__device__ __forceinline__ float gelu_tanh(float x) { return 0.5f * x * (1.f + tanhf(0.7978845608028654f * (x + 0.044715f * x * x * x))); }
__device__ __forceinline__ float sigmoidf(float x) { return 1.f / (1.f + expf(-x)); }
__device__ __forceinline__ float siluf(float x) { return x / (1.f + expf(-x)); }

struct Params {
    const float* x; const float* mem; const float* w_in; const float* gm_ln_g; const float* gm_ln_b; const float* gm_ws; const float* gm_bs;
    const float* cmp_pos_k; const float* cmp_k_w1; const float* cmp_k_w2; const float* cmp_pos_v; const float* cmp_v_w1; const float* cmp_v_w2;
    const float* w_mem_kv; const float* w_out; const float* ln_g; const float* ln_b;
    float* out; char* ws;
};

__device__ __forceinline__ void transpose_tile(const float* W, int K, int N, bf16_t* WT, int mode, int tp, int tk, float* t, int htid, bool active) {
    const int tx = htid & 31, ty = htid >> 5, p0 = tp * 32, k0 = tk * 32, p = p0 + tx;
    int c;
    if (mode == 0) c = p < N ? p : -1;
    else { if (p < 2048) c = p; else if (p < 3072) c = p + 24; else if (p < 3096) c = p - 1024; else c = -1; }
    if (active) for (int i = ty; i < 32; i += 8) t[i * 33 + tx] = (c >= 0) ? W[(size_t)(k0 + i) * N + c] : 0.f;
    __syncthreads();
    if (active) for (int i = ty; i < 32; i += 8) WT[(size_t)(p0 + i) * K + k0 + tx] = f2bf(t[tx * 33 + i]);
    __syncthreads();
}

struct EpiArgs { bf16_t* H; const float* rope; const float* resid; float* out; bf16_t* QN; bf16_t* MQ; bf16_t* kvbase; bf16_t* MK; bf16_t* MVT; };

template <int EPI>
__device__ __forceinline__ void gemm_tile(const bf16_t* A, const bf16_t* Bt, int K, int m0, int n0, const EpiArgs& ea, bf16_t* As, bf16_t* Bs, int tid, bool active) {
    const int lane = tid & 63, wid = tid >> 6, wr = wid >> 1, wc = wid & 1;
    f32x4 acc[4][4];
#pragma unroll
    for (int i = 0; i < 4; ++i)
#pragma unroll
        for (int j = 0; j < 4; ++j) acc[i][j] = (f32x4){0.f, 0.f, 0.f, 0.f};
    const int lr0 = tid >> 2, lk = (tid & 3) * 8;
    const bf16_t* ap = A + (size_t)(m0 + lr0) * K + lk;
    const bf16_t* bp = Bt + (size_t)(n0 + lr0) * K + lk;
    uint4 ra0 = *(const uint4*)ap, ra1 = *(const uint4*)(ap + (size_t)64 * K);
    uint4 rb0 = *(const uint4*)bp, rb1 = *(const uint4*)(bp + (size_t)64 * K);
    for (int k0 = 0; k0 < K; k0 += 32) {
        __syncthreads();
        *(uint4*)&As[lr0 * 40 + lk] = ra0; *(uint4*)&As[(lr0 + 64) * 40 + lk] = ra1;
        *(uint4*)&Bs[lr0 * 40 + lk] = rb0; *(uint4*)&Bs[(lr0 + 64) * 40 + lk] = rb1;
        __syncthreads();
        if (k0 + 32 < K) {
            ra0 = *(const uint4*)(ap + k0 + 32); ra1 = *(const uint4*)(ap + (size_t)64 * K + k0 + 32);
            rb0 = *(const uint4*)(bp + k0 + 32); rb1 = *(const uint4*)(bp + (size_t)64 * K + k0 + 32);
        }
        bf16x8 af[4], bfr[4];
#pragma unroll
        for (int i = 0; i < 4; ++i) {
            af[i] = *(const bf16x8*)&As[(wr * 64 + i * 16 + (lane & 15)) * 40 + (lane >> 4) * 8];
            bfr[i] = *(const bf16x8*)&Bs[(wc * 64 + i * 16 + (lane & 15)) * 40 + (lane >> 4) * 8];
        }
#pragma unroll
        for (int i = 0; i < 4; ++i)
#pragma unroll
            for (int j = 0; j < 4; ++j) acc[i][j] = __builtin_amdgcn_mfma_f32_16x16x32_bf16(bfr[j], af[i], acc[i][j], 0, 0, 0);
    }
    if (!active) return;
    const int tk = lane & 15, nq = lane >> 4;
    const int cb = n0 + wc * 64;
    if (EPI == 0) {
        int type;
        if (cb < 512) type = 0; else if (cb < 768) type = 1; else if (cb < 1280) type = 2;
        else if (cb < 2048) type = ((((cb - 1280) >> 6) >> 1) & 1) ? 4 : 3;
        else if (cb < 2560) type = 1; else if (cb < 2816) type = 5; else if (cb < 3072) type = 1; else type = 6;
        const float qscale = 0.125f * LOG2E_F;
#pragma unroll
        for (int mt = 0; mt < 4; ++mt) {
            const int token = m0 + wr * 64 + mt * 16 + tk;
            f32x4 v[4];
#pragma unroll
            for (int nt = 0; nt < 4; ++nt) v[nt] = acc[mt][nt];
            if (type == 0) {
#pragma unroll
                for (int nt = 0; nt < 4; ++nt)
#pragma unroll
                    for (int r = 0; r < 4; ++r) v[nt][r] = gelu_erf(v[nt][r]);
            } else if (type == 1) {
#pragma unroll
                for (int nt = 0; nt < 4; ++nt)
#pragma unroll
                    for (int r = 0; r < 4; ++r) v[nt][r] = siluf(v[nt][r]);
            } else if (type == 2 || type == 3) {
                const int pos = token & (SEQ - 1);
                const float sc = (type == 2) ? qscale : 1.f;
#pragma unroll
                for (int nt = 0; nt < 2; ++nt) {
                    const f32x4 cs = *(const f32x4*)(ea.rope + pos * 32 + nt * 16 + nq * 4);
                    const f32x4 sn = *(const f32x4*)(ea.rope + 8192 * 32 + pos * 32 + nt * 16 + nq * 4);
#pragma unroll
                    for (int r = 0; r < 4; ++r) {
                        const float x1 = v[nt][r], x2 = v[nt + 2][r];
                        v[nt][r] = (x1 * cs[r] - x2 * sn[r]) * sc;
                        v[nt + 2][r] = (x2 * cs[r] + x1 * sn[r]) * sc;
                    }
                }
            } else if (type == 5) {
#pragma unroll
                for (int nt = 0; nt < 4; ++nt)
#pragma unroll
                    for (int r = 0; r < 4; ++r) v[nt][r] *= qscale;
            } else if (type == 6) {
#pragma unroll
                for (int nt = 0; nt < 4; ++nt)
#pragma unroll
                    for (int r = 0; r < 4; ++r) v[nt][r] = sigmoidf(v[nt][r]);
            }
            bf16_t* dst; bool transposed = false;
            if (cb < 768) dst = ea.H + (size_t)token * HP2 + cb;
            else if (cb < 1280) dst = ea.QN + (size_t)token * 512 + (cb - 768);
            else if (cb < 2048) {
                const int idx = (cb - 1280) >> 6, g = idx & 1, kind = idx >> 1, bg = (token >> 13) * 2 + g, t = token & (SEQ - 1);
                bf16_t* kb = ea.kvbase + (size_t)kind * 4 * SEQ * 64;
                if (kind == 3 || kind == 5) { transposed = true; dst = kb + (size_t)(bg * 64) * SEQ + t; }
                else dst = kb + ((size_t)bg * SEQ + t) * 64;
            }
            else if (cb < 2560) dst = ea.H + (size_t)token * HP2 + C_NZ + (cb - 2048);
            else if (cb < 2816) dst = ea.MQ + (size_t)token * 256 + (cb - 2560);
            else if (cb < 3072) dst = ea.H + (size_t)token * HP2 + C_MZ + (cb - 2816);
            else dst = ea.H + (size_t)token * HP2 + C_GATE + (cb - 3072);
            if (cb >= 3136) {   }
            else if (!transposed) {
#pragma unroll
                for (int nt = 0; nt < 4; ++nt) { uint2 w; w.x = cvtpk(v[nt][0], v[nt][1]); w.y = cvtpk(v[nt][2], v[nt][3]); *(uint2*)(dst + nt * 16 + nq * 4) = w; }
            } else {
#pragma unroll
                for (int nt = 0; nt < 4; ++nt)
#pragma unroll
                    for (int r = 0; r < 4; ++r) dst[(size_t)(nt * 16 + nq * 4 + r) * SEQ] = f2bf(v[nt][r]);
            }
        }
    } else if (EPI == 1) {
#pragma unroll
        for (int mt = 0; mt < 4; ++mt) {
            const int row = m0 + wr * 64 + mt * 16 + tk, b = row >> 8, m = row & 255;
            if (cb < 256) {
                const int h = cb >> 6;
#pragma unroll
                for (int nt = 0; nt < 4; ++nt) { uint2 w; w.x = cvtpk(acc[mt][nt][0], acc[mt][nt][1]); w.y = cvtpk(acc[mt][nt][2], acc[mt][nt][3]); *(uint2*)(ea.MK + ((size_t)((b * 4 + h) * 256 + m)) * 64 + nt * 16 + nq * 4) = w; }
            } else {
                const int h = (cb - 256) >> 6;
#pragma unroll
                for (int nt = 0; nt < 4; ++nt)
#pragma unroll
                    for (int r = 0; r < 4; ++r) ea.MVT[((size_t)((b * 4 + h) * 64 + nt * 16 + nq * 4 + r)) * 256 + m] = f2bf(acc[mt][nt][r]);
            }
        }
    } else {
#pragma unroll
        for (int mt = 0; mt < 4; ++mt) {
            const int token = m0 + wr * 64 + mt * 16 + tk;
#pragma unroll
            for (int nt = 0; nt < 4; ++nt) {
                const size_t off = (size_t)token * 1024 + cb + nt * 16 + nq * 4;
                const f32x4 rs = *(const f32x4*)(ea.resid + off);
                f32x4 o;
#pragma unroll
                for (int r = 0; r < 4; ++r) o[r] = ALPHA_F * rs[r] + acc[mt][nt][r];
                *(f32x4*)(ea.out + off) = o;
            }
        }
    }
}

template <int EPI>
__device__ __forceinline__ void gemm_phase(const bf16_t* A, const bf16_t* Bt, int K, int ntm, int ntn, const EpiArgs& ea, char* lds, int bid, int nb, int tid) {
    const int half = tid >> 8, htid = tid & 255;
    bf16_t* As = (bf16_t*)(lds + half * 20480); bf16_t* Bs = As + 128 * 40;
    const int nt = ntm * ntn;
    for (int t0 = bid * 2; t0 < nt; t0 += nb * 2) {
        const int t = t0 + half; const bool active = t < nt; const int tt = active ? t : nt - 1;
        gemm_tile<EPI>(A, Bt, K, (tt / ntn) * 128, (tt % ntn) * 128, ea, As, Bs, htid, active);
    }
    __syncthreads();
}

__device__ __forceinline__ void ln_row(float* buf, const float* g, const float* b, bf16_t* xb, int row, int lane) {
    float4* x4 = (float4*)(buf + (size_t)row * 1024);
    float4 v[4]; float s = 0.f;
#pragma unroll
    for (int j = 0; j < 4; ++j) { v[j] = x4[lane + 64 * j]; s += (v[j].x + v[j].y) + (v[j].z + v[j].w); }
    const float mean = wave_sum(s) * (1.f / 1024.f);
    float q = 0.f;
#pragma unroll
    for (int j = 0; j < 4; ++j) { v[j].x -= mean; v[j].y -= mean; v[j].z -= mean; v[j].w -= mean; q += (v[j].x * v[j].x + v[j].y * v[j].y) + (v[j].z * v[j].z + v[j].w * v[j].w); }
    const float rstd = rsqrtf(wave_sum(q) * (1.f / 1024.f) + LN_EPS_F);
#pragma unroll
    for (int j = 0; j < 4; ++j) {
        const float4 gg = ((const float4*)g)[lane + 64 * j], bb = ((const float4*)b)[lane + 64 * j];
        float4 o; o.x = v[j].x * rstd * gg.x + bb.x; o.y = v[j].y * rstd * gg.y + bb.y; o.z = v[j].z * rstd * gg.z + bb.z; o.w = v[j].w * rstd * gg.w + bb.w;
        x4[lane + 64 * j] = o;
        if (xb) { uint2 r; r.x = f2bf(o.x) | ((unsigned)f2bf(o.y) << 16); r.y = f2bf(o.z) | ((unsigned)f2bf(o.w) << 16); ((uint2*)(xb + (size_t)row * 1024))[lane + 64 * j] = r; }
    }
}

__device__ __forceinline__ void gmlp_unit(const bf16_t* H, const float* lng, const float* lnb, const float* ws, const float* bs, bf16_t* MIX, int unit, float* vl, int htid) {
    const int g = unit & 3, ch = unit >> 2;
    const int row0 = ch * 128;
    const int lane = htid & 63, w = htid >> 6;
    for (int r = w * 32; r < w * 32 + 32; ++r) {
        const float v = bf2f(H[(size_t)(row0 + r) * HP2 + C_V + g * 64 + lane]);
        const float mean = wave_sum(v) * (1.f / 64.f);
        const float d = v - mean;
        const float var = wave_sum(d * d) * (1.f / 64.f);
        vl[r * 64 + lane] = d * rsqrtf(var + LN_EPS_F) * lng[g * 64 + lane] + lnb[g * 64 + lane];
    }
    __syncthreads();
    const int c = lane;
    for (int i = w; i < 128; i += 4) {
        const float* wrow = ws + (size_t)(g * 128 + i) * 128;
        float acc = 0.f;
        for (int j = 0; j <= i; ++j) acc += wrow[j] * vl[j * 64 + c];
        const float s = acc + bs[g * 128 + i];
        const size_t hro = (size_t)(row0 + i) * HP2;
        const float u = bf2f(H[hro + C_U + g * 64 + c]), z = bf2f(H[hro + C_Z + g * 64 + c]);
        MIX[(size_t)(row0 + i) * 1024 + g * 64 + c] = f2bf(u * s * z);
    }
    __syncthreads();
}

__device__ __forceinline__ void compress_unit(const bf16_t* KCR, const bf16_t* VCR, const Params& p, int l, bf16_t* KC, bf16_t* VCT, int unit, float* lq, int qtid) {
    float* blk = lq; float* pe = lq + 80 * 64; float* hid = pe + 32 * 64;
    const int ng = unit & 127, g = (unit >> 7) & 1, b = (unit >> 8) & 1, which = unit >> 9, bg = b * 2 + g;
    const float* pos = (which ? p.cmp_pos_v : p.cmp_pos_k) + l * 2048;
    const float* w1 = (which ? p.cmp_v_w1 : p.cmp_k_w1) + (size_t)l * 2048 * 128;
    const float* w2 = (which ? p.cmp_v_w2 : p.cmp_k_w2) + l * 128 * 64;
    const bf16_t* srcp = (which ? VCR : KCR) + (size_t)bg * SEQ * 64;
    const int n0 = ng * 4, tok0 = n0 * 16;
    for (int e = qtid; e < 80 * 64; e += 128) { const int r = e >> 6, d = e & 63, tok = tok0 + r; blk[e] = tok < SEQ ? bf2f(srcp[(size_t)tok * 64 + d]) : 0.f; }
    for (int e = qtid; e < 32 * 64; e += 128) pe[e] = pos[e];
    __syncthreads();
    float acc[4] = {0.f, 0.f, 0.f, 0.f};
    for (int l2 = 0; l2 < 32; ++l2)
        for (int d = 0; d < 64; ++d) {
            const float wv = w1[(size_t)(l2 * 64 + d) * 128 + qtid], pp = pe[l2 * 64 + d];
#pragma unroll
            for (int r = 0; r < 4; ++r) acc[r] += (blk[(16 * r + l2) * 64 + d] + pp) * wv;
        }
#pragma unroll
    for (int r = 0; r < 4; ++r) hid[r * 128 + qtid] = gelu_tanh(acc[r]);
    __syncthreads();
    for (int o = qtid; o < 256; o += 128) {
        const int r = o >> 6, c = o & 63, n = n0 + r;
        float s = 0.f; for (int hh = 0; hh < 128; ++hh) s += hid[r * 128 + hh] * w2[hh * 64 + c];
        if (n >= 511) s = 0.f;
        if (which) VCT[((size_t)(bg * 64 + c)) * 512 + n] = f2bf(s); else KC[((size_t)(bg * 512 + n)) * 64 + c] = f2bf(s);
    }
    __syncthreads();
}

#define WAVE_LDS_SYNC() do { asm volatile("s_waitcnt lgkmcnt(0)" ::: "memory"); __builtin_amdgcn_wave_barrier(); } while (0)
#define MFMA32(a, b, c) __builtin_amdgcn_mfma_f32_32x32x16_bf16((a), (b), (c), 0, 0, 0)
#define MFMA16(a, b, c) __builtin_amdgcn_mfma_f32_16x16x32_bf16((a), (b), (c), 0, 0, 0)
#define EXP2(x) __builtin_amdgcn_exp2f(x)

constexpr int ATT_STAGE = 18432;
constexpr int ATT_WSF = 2 * ATT_STAGE;
struct DenseArgs { const bf16_t* Q; int qpitch; const bf16_t* K; const bf16_t* Vt; int vpitch; const bf16_t* H; const bf16_t* OWr; const bf16_t* OCr; bf16_t* OWw; bf16_t* MIX; const unsigned* SELM; };

template <int MODE>
__device__ __forceinline__ void dense_unit(const DenseArgs& a, int unit, char* lds, int tid) {
    const int lane = tid & 63, wave = tid >> 6, r32 = lane & 31, hi = lane >> 5;
    int b, g, hq, qblk, tok0, ntiles, kstart, kstep, qrel0;
    if (MODE == 2) { b = unit >> 7; g = (unit >> 5) & 3; hq = g; qblk = 0; tok0 = (unit & 31) * 256 + wave * 32; ntiles = 4; kstart = 0; kstep = 64; qrel0 = 0; }
    else { const int bg = unit >> 7; b = bg >> 1; g = bg & 1; qblk = unit & 127; hq = g * 4 + (wave >> 1); qrel0 = (wave & 1) * 32; tok0 = qblk * 64 + qrel0; kstart = qblk * 64; kstep = -64;
           ntiles = (MODE == 0) ? 1 + (qblk < 8 ? qblk : 8) : qblk + 1; }
    const bf16_t* Kb = a.K + (size_t)((MODE == 2) ? (b * 4 + g) * 256 : (b * 2 + g) * SEQ) * 64;
    const bf16_t* Vb = a.Vt + (size_t)((MODE == 2) ? (b * 4 + g) * 64 : (b * 2 + g) * 64) * a.vpitch;
    const bf16_t* qp = a.Q + (size_t)(b * SEQ + tok0 + r32) * a.qpitch + hq * 64 + hi * 8;
    bf16x8 qr[4];
#pragma unroll
    for (int d0 = 0; d0 < 4; ++d0) qr[d0] = *(const bf16x8*)(qp + d0 * 16);
    uint4 sm = make_uint4(0u, 0u, 0u, 0u);
    if (MODE == 1) sm = *(const uint4*)(a.SELM + ((size_t)((b * 2 + g) * SEQ) + tok0 + r32) * 4);
    float mref = -INFINITY, l = 0.f;
    f32x16 o0, o1;
#pragma unroll
    for (int r = 0; r < 16; ++r) { o0[r] = 0.f; o1[r] = 0.f; }
    float* wsf = (float*)(lds + ATT_WSF + wave * 128);
    const int srow = tid >> 3, sch = tid & 7;
    const int qrel = qrel0 + r32;
    uint4 kreg, vreg;
    { const int key0 = kstart; kreg = *(const uint4*)(Kb + (size_t)(key0 + srow) * 64 + sch * 8); vreg = *(const uint4*)(Vb + (size_t)srow * a.vpitch + key0 + sch * 8); }
    *(uint4*)(lds + srow * 144 + sch * 16) = kreg; *(uint4*)(lds + 9216 + srow * 144 + sch * 16) = vreg;
    __syncthreads();
    for (int i = 0; i < ntiles; ++i) {
        if (i + 1 < ntiles) { const int key0 = kstart + (i + 1) * kstep; kreg = *(const uint4*)(Kb + (size_t)(key0 + srow) * 64 + sch * 8); vreg = *(const uint4*)(Vb + (size_t)srow * a.vpitch + key0 + sch * 8); }
        const char* Ks = lds + (i & 1) * ATT_STAGE; const char* Vs = Ks + 9216;
        f32x16 p0, p1;
#pragma unroll
        for (int r = 0; r < 16; ++r) { p0[r] = 0.f; p1[r] = 0.f; }
#pragma unroll
        for (int d0 = 0; d0 < 4; ++d0) {
            const bf16x8 k0 = *(const bf16x8*)(Ks + r32 * 144 + d0 * 32 + hi * 16), k1 = *(const bf16x8*)(Ks + (32 + r32) * 144 + d0 * 32 + hi * 16);
            p0 = MFMA32(k0, qr[d0], p0); p1 = MFMA32(k1, qr[d0], p1);
        }
        if (MODE != 2 && i == 0) {
#pragma unroll
            for (int r = 0; r < 16; ++r) { const int kr = crow(r, hi); if (kr > qrel) p0[r] = -INFINITY; if (kr + 32 > qrel) p1[r] = -INFINITY; }
        }
        if (MODE == 0 && i == 8) {
#pragma unroll
            for (int r = 0; r < 16; ++r) { const int kr = crow(r, hi); if (kr <= qrel) p0[r] = -INFINITY; if (kr + 32 <= qrel) p1[r] = -INFINITY; }
        }
        if (MODE == 1) {
            const int j = qblk - i;
            const unsigned wd = j < 32 ? sm.x : (j < 64 ? sm.y : (j < 96 ? sm.z : sm.w));
            if (!((wd >> (j & 31)) & 1u)) {
#pragma unroll
                for (int r = 0; r < 16; ++r) { p0[r] = -INFINITY; p1[r] = -INFINITY; }
            }
        }
        float mx = fmaxf(p0[0], p1[0]);
#pragma unroll
        for (int r = 1; r < 16; ++r) mx = fmaxf(mx, fmaxf(p0[r], p1[r]));
        mx = fmaxf(mx, __shfl_xor(mx, 32));
        if (__any(mx > mref + 8.f)) {
            const float mnew = fmaxf(mref, mx), alpha = EXP2(mref - mnew);
            l *= alpha; mref = mnew;
            if (hi == 0) wsf[r32] = alpha;
            WAVE_LDS_SYNC();
#pragma unroll
            for (int r = 0; r < 16; ++r) { const float af = wsf[crow(r, hi)]; o0[r] *= af; o1[r] *= af; }
            WAVE_LDS_SYNC();
        }
        float ls = 0.f;
#pragma unroll
        for (int r = 0; r < 16; ++r) { p0[r] = EXP2(p0[r] - mref); p1[r] = EXP2(p1[r] - mref); ls += p0[r] + p1[r]; }
        l += ls;
#pragma unroll
        for (int s = 0; s < 4; ++s) {
            uint4 pw;
            if (s == 0) pw = make_uint4(cvtpk(p0[0], p0[1]), cvtpk(p0[2], p0[3]), cvtpk(p0[4], p0[5]), cvtpk(p0[6], p0[7]));
            else if (s == 1) pw = make_uint4(cvtpk(p0[8], p0[9]), cvtpk(p0[10], p0[11]), cvtpk(p0[12], p0[13]), cvtpk(p0[14], p0[15]));
            else if (s == 2) pw = make_uint4(cvtpk(p1[0], p1[1]), cvtpk(p1[2], p1[3]), cvtpk(p1[4], p1[5]), cvtpk(p1[6], p1[7]));
            else pw = make_uint4(cvtpk(p1[8], p1[9]), cvtpk(p1[10], p1[11]), cvtpk(p1[12], p1[13]), cvtpk(p1[14], p1[15]));
            const bf16x8 pa = __builtin_bit_cast(bf16x8, pw);
            const uint2 a0 = *(const uint2*)(Vs + r32 * 144 + (16 * s + 4 * hi) * 2), a1 = *(const uint2*)(Vs + r32 * 144 + (16 * s + 8 + 4 * hi) * 2);
            const uint2 b0 = *(const uint2*)(Vs + (32 + r32) * 144 + (16 * s + 4 * hi) * 2), b1 = *(const uint2*)(Vs + (32 + r32) * 144 + (16 * s + 8 + 4 * hi) * 2);
            o0 = MFMA32(pa, __builtin_bit_cast(bf16x8, make_uint4(a0.x, a0.y, a1.x, a1.y)), o0);
            o1 = MFMA32(pa, __builtin_bit_cast(bf16x8, make_uint4(b0.x, b0.y, b1.x, b1.y)), o1);
        }
        if (i + 1 < ntiles) { char* dst = lds + ((i + 1) & 1) * ATT_STAGE; *(uint4*)(dst + srow * 144 + sch * 16) = kreg; *(uint4*)(dst + 9216 + srow * 144 + sch * 16) = vreg; }
        __syncthreads();
    }
    l += __shfl_xor(l, 32);
    if (hi == 0) wsf[r32] = 1.f / l;
    WAVE_LDS_SYNC();
#pragma unroll
    for (int r = 0; r < 16; ++r) {
        const int q = crow(r, hi); const float inv = wsf[q];
        const size_t token = (size_t)b * SEQ + tok0 + q;
        const float v0 = o0[r] * inv, v1 = o1[r] * inv;
        if (MODE == 0) { bf16_t* d = a.OWw + token * 512 + hq * 64; d[r32] = f2bf(v0); d[32 + r32] = f2bf(v1); }
        else if (MODE == 2) {
            const bf16_t* z = a.H + token * HP2 + C_MZ + hq * 64; bf16_t* d = a.MIX + token * 1024 + 768 + hq * 64;
            d[r32] = f2bf(v0 * bf2f(z[r32])); d[32 + r32] = f2bf(v1 * bf2f(z[32 + r32]));
        } else {
            const bf16_t* hrow = a.H + token * HP2;
            const float gc = bf2f(hrow[C_GATE + hq * 3 + 0]), gs = bf2f(hrow[C_GATE + hq * 3 + 1]), gw = bf2f(hrow[C_GATE + hq * 3 + 2]);
            const bf16_t* z = hrow + C_NZ + hq * 64; const bf16_t* ow = a.OWr + token * 512 + hq * 64; const bf16_t* oc = a.OCr + token * 512 + hq * 64;
            bf16_t* d = a.MIX + token * 1024 + 256 + hq * 64;
            d[r32] = f2bf((v0 * gs + bf2f(ow[r32]) * gw + bf2f(oc[r32]) * gc) * bf2f(z[r32]));
            d[32 + r32] = f2bf((v1 * gs + bf2f(ow[32 + r32]) * gw + bf2f(oc[32 + r32]) * gc) * bf2f(z[32 + r32]));
        }
    }
    WAVE_LDS_SYNC();
}

__device__ __forceinline__ f32x4 cmp_scores(const bf16_t* kp, int m, const bf16x8& qb0, const bf16x8& qb1, int g4, int nvis) {
    const bf16x8 k0 = *(const bf16x8*)(kp + m * 1024), k1 = *(const bf16x8*)(kp + m * 1024 + 32);
    f32x4 z = {0.f, 0.f, 0.f, 0.f};
    z = MFMA16(k0, qb0, z); z = MFMA16(k1, qb1, z);
#pragma unroll
    for (int r = 0; r < 4; ++r) if (m * 16 + 4 * g4 + r >= nvis) z[r] = -INFINITY;
    return z;
}
__device__ __forceinline__ void cmp_item(const bf16_t* QN, const bf16_t* KC, const bf16_t* VCT, bf16_t* OC, unsigned* SELM, int bg, int tq, int lane, float* impL) {
    const int b = bg >> 1, g = bg & 1, t0 = tq * 4;
    const int col = lane & 15, g4 = lane >> 4, qi = col >> 2, hl = col & 3;
    const int t = t0 + qi;
    const int nvis = t >= 31 ? ((t - 31) >> 4) + 1 : 0;
    const int tl = t0 + 3, nmax = tl >= 31 ? ((tl - 31) >> 4) + 1 : 0;
    const int npair = (nmax + 31) >> 5;
    const bf16_t* qp = QN + (size_t)(b * SEQ + t) * 512 + (g * 4 + hl) * 64 + g4 * 8;
    const bf16x8 qb0 = *(const bf16x8*)qp, qb1 = *(const bf16x8*)(qp + 32);
    const bf16_t* kp = KC + ((size_t)(bg * 512) + col) * 64 + g4 * 8;
#pragma unroll
    for (int e = 0; e < 8; ++e) impL[e * 64 + lane] = 0.f;
    float ml = -INFINITY, sl = 0.f;
    for (int m = 0; m < 2 * npair; ++m) {
        const f32x4 z = cmp_scores(kp, m, qb0, qb1, g4, nvis);
        const float tm = fmaxf(fmaxf(z[0], z[1]), fmaxf(z[2], z[3]));
        if (tm > -INFINITY) {
            const float mn = fmaxf(ml, tm);
            sl = sl * EXP2(ml - mn) + (EXP2(z[0] - mn) + EXP2(z[1] - mn)) + (EXP2(z[2] - mn) + EXP2(z[3] - mn));
            ml = mn;
        }
    }
    float M = fmaxf(ml, __shfl_xor(ml, 16)); M = fmaxf(M, __shfl_xor(M, 32));
    float sp = (ml > -INFINITY) ? sl * EXP2(ml - M) : 0.f;
    sp += __shfl_xor(sp, 16); sp += __shfl_xor(sp, 32);
    const float inv = sp > 0.f ? 1.f / sp : 0.f;
    const float Ms = (M > -INFINITY) ? M : 0.f;
    WAVE_LDS_SYNC();
    f32x4 acc[4];
#pragma unroll
    for (int dt = 0; dt < 4; ++dt) acc[dt] = (f32x4){0.f, 0.f, 0.f, 0.f};
    const bf16_t* vp = VCT + ((size_t)(bg * 64) + col) * 512 + g4 * 4;
    float c3prev = 0.f;
    for (int i = 0; i < npair; ++i) {
        f32x4 pp[2];
#pragma unroll
        for (int u = 0; u < 2; ++u) {
            const int m = 2 * i + u;
            f32x4 z = cmp_scores(kp, m, qb0, qb1, g4, nvis);
#pragma unroll
            for (int r = 0; r < 4; ++r) z[r] = EXP2(z[r] - Ms) * inv;
            pp[u] = z;
            float av = (z[0] + z[1]) + (z[2] + z[3]), c3 = z[3];
            av += __shfl_xor(av, 1); av += __shfl_xor(av, 2); c3 += __shfl_xor(c3, 1); c3 += __shfl_xor(c3, 2);
            const float from_group = __shfl(c3, (lane + 48) & 63);
            const float from_tile = __shfl(c3prev, (lane + 48) & 63);
            if (hl == 0) impL[qi * 128 + 4 * m + g4] = av + (g4 > 0 ? from_group : from_tile);
            c3prev = c3;
        }
        const uint4 pw = make_uint4(cvtpk(pp[0][0], pp[0][1]), cvtpk(pp[0][2], pp[0][3]), cvtpk(pp[1][0], pp[1][1]), cvtpk(pp[1][2], pp[1][3]));
        const bf16x8 pb = __builtin_bit_cast(bf16x8, pw);
#pragma unroll
        for (int dt = 0; dt < 4; ++dt) {
            const uint2 lo = *(const uint2*)(vp + dt * 8192 + i * 32), hv = *(const uint2*)(vp + dt * 8192 + i * 32 + 16);
            acc[dt] = MFMA16(__builtin_bit_cast(bf16x8, make_uint4(lo.x, lo.y, hv.x, hv.y)), pb, acc[dt]);
        }
    }
    {
        const float from_tile = __shfl(c3prev, (lane + 48) & 63);
        if (npair < 16 && g4 == 0 && hl == 0) impL[qi * 128 + 8 * npair] = from_tile;
    }
    {
        bf16_t* op = OC + (size_t)(b * SEQ + t) * 512 + (g * 4 + hl) * 64 + g4 * 4;
#pragma unroll
        for (int dt = 0; dt < 4; ++dt) { uint2 w; w.x = cvtpk(acc[dt][0], acc[dt][1]); w.y = cvtpk(acc[dt][2], acc[dt][3]); *(uint2*)(op + dt * 16) = w; }
    }
    WAVE_LDS_SYNC();
    const int tblk = t0 >> 6, sub = g4 * 4 + hl;
    float val[8];
#pragma unroll
    for (int e = 0; e < 8; ++e) { const int j = e * 16 + sub; const bool valid = j <= tblk, forced = (j == 0) || (valid && j > tblk - 2); const float im = impL[qi * 128 + j]; val[e] = forced ? 1e4f : (valid ? im : -1.f); }
    unsigned w0 = 0u, w1 = 0u, w2 = 0u, w3 = 0u;
    for (int k = 0; k < 16; ++k) {
        float bv = val[0]; int be = 0;
#pragma unroll
        for (int e = 1; e < 8; ++e) if (val[e] > bv) { bv = val[e]; be = e; }
        int bj = be * 16 + sub;
#pragma unroll
        for (int o = 1; o <= 32; o <<= 1) {
            if (o == 4 || o == 8) continue;
            const float ov = __shfl_xor(bv, o); const int oj = __shfl_xor(bj, o); if (ov > bv || (ov == bv && oj < bj)) { bv = ov; bj = oj; }
        }
        if (__all(bv < 0.f)) break;
        if (bv >= 0.f) { const unsigned bit = 1u << (bj & 31); const int wd = bj >> 5; w0 |= (wd == 0) ? bit : 0u; w1 |= (wd == 1) ? bit : 0u; w2 |= (wd == 2) ? bit : 0u; w3 |= (wd == 3) ? bit : 0u; }
        const int mine = ((bj & 15) == sub) ? (bj >> 4) : -1;
#pragma unroll
        for (int e = 0; e < 8; ++e) if (e == mine) val[e] = -2.f;
    }
    if (sub == 0) *(uint4*)(SELM + ((size_t)(bg * SEQ) + t) * 4) = make_uint4(w0, w1, w2, w3);
    WAVE_LDS_SYNC();
}

#define FRESH_TID() int tid = threadIdx.x; asm volatile("" : "+v"(tid)); const int lane = tid & 63, wave = tid >> 6; (void)lane; (void)wave
__global__ __launch_bounds__(NTHREADS) void mega(Params p) {
    extern __shared__ __attribute__((aligned(16))) char lds[];
    cg::grid_group grid = cg::this_grid();
    const int bid = blockIdx.x, nb = gridDim.x;
    char* ws = p.ws;
    bf16_t* H = (bf16_t*)(ws + WS_H); bf16_t* XB = (bf16_t*)(ws + WS_XB); bf16_t* MIX = (bf16_t*)(ws + WS_MIX);
    bf16_t* QN = (bf16_t*)(ws + WS_QN); bf16_t* MQ = (bf16_t*)(ws + WS_MQ);
    bf16_t* KCR = (bf16_t*)(ws + WS_KCR); bf16_t* VCR = (bf16_t*)(ws + WS_VCR); bf16_t* KS = (bf16_t*)(ws + WS_KS); bf16_t* KW = (bf16_t*)(ws + WS_KW);
    bf16_t* VST = (bf16_t*)(ws + WS_VST); bf16_t* VWT = (bf16_t*)(ws + WS_VWT); bf16_t* OW = (bf16_t*)(ws + WS_OW); bf16_t* OC = (bf16_t*)(ws + WS_OC);
    bf16_t* WIN = (bf16_t*)(ws + WS_WIN); bf16_t* WOUT = (bf16_t*)(ws + WS_WOUT); bf16_t* WMEM = (bf16_t*)(ws + WS_WMEM);
    bf16_t* MEMB = (bf16_t*)(ws + WS_MEMB); bf16_t* MK = (bf16_t*)(ws + WS_MK); bf16_t* MVT = (bf16_t*)(ws + WS_MVT); float* ROPE = (float*)(ws + WS_ROPE);
    bf16_t* KC = (bf16_t*)(ws + WS_KCMP); bf16_t* VCT = (bf16_t*)(ws + WS_VCMPT); unsigned* SELM = (unsigned*)(ws + WS_SELM);

    {
        FRESH_TID();
        const int half = tid >> 8, htid = tid & 255;
        float* tl = (float*)(lds + half * 4352);
        constexpr int U_IN = 100 * 32, U_OUT = 32 * 32, U_MEM = 16 * 32, U_L = U_IN + U_OUT + U_MEM, U_ALL = 2 * U_L;
        for (int u0 = bid * 2; u0 < U_ALL; u0 += nb * 2) {
            const int u = u0 + half; const bool active = u < U_ALL; const int uu = active ? u : U_ALL - 1;
            const int l = uu / U_L; int r = uu % U_L;
            if (r < U_IN) transpose_tile(p.w_in + (size_t)l * 1024 * INCOLS, 1024, INCOLS, WIN + (size_t)l * HP * 1024, 1, r >> 5, r & 31, tl, htid, active);
            else if (r < U_IN + U_OUT) { r -= U_IN; transpose_tile(p.w_out + (size_t)l * 1024 * 1024, 1024, 1024, WOUT + (size_t)l * 1024 * 1024, 0, r >> 5, r & 31, tl, htid, active); }
            else { r -= U_IN + U_OUT; transpose_tile(p.w_mem_kv + (size_t)l * 1024 * 512, 1024, 512, WMEM + (size_t)l * 512 * 1024, 0, r >> 5, r & 31, tl, htid, active); }
        }
        const int gt = bid * NTHREADS + tid, gs = nb * NTHREADS;
        for (int i = gt; i < TOK * 1024 / 4; i += gs) { const float4 v = ((const float4*)p.x)[i]; uint2 r; r.x = cvtpk(v.x, v.y); r.y = cvtpk(v.z, v.w); ((uint2*)XB)[i] = r; }
        for (int i = gt; i < 512 * 1024 / 4; i += gs) { const float4 v = ((const float4*)p.mem)[i]; uint2 r; r.x = cvtpk(v.x, v.y); r.y = cvtpk(v.z, v.w); ((uint2*)MEMB)[i] = r; }
        for (int i = gt; i < 8192 * 32; i += gs) { const int pos = i >> 5, f = i & 31; const float inv = powf(10000.f, -(float)f * 2.0f / 64.0f); const float a = (float)pos * inv; ROPE[i] = cosf(a); ROPE[8192 * 32 + i] = sinf(a); }
    }
    grid.sync();
    for (int l = 0; l < 2; ++l) { FRESH_TID(); EpiArgs e{}; e.MK = MK + (size_t)l * 8 * 256 * 64; e.MVT = MVT + (size_t)l * 8 * 256 * 64; gemm_phase<1>(MEMB, WMEM + (size_t)l * 512 * 1024, 1024, 4, 4, e, lds, bid, nb, tid); }

    for (int l = 0; l < 2; ++l) {
        { FRESH_TID(); EpiArgs e{}; e.H = H; e.rope = ROPE; e.QN = QN; e.MQ = MQ; e.kvbase = KCR;
          gemm_phase<0>(XB, WIN + (size_t)l * HP * 1024, 1024, TOK / 128, HP / 128, e, lds, bid, nb, tid); }
        grid.sync();
        {
            FRESH_TID();
            const int q = tid >> 7, qtid = tid & 127;
            for (int u0 = bid * 4; u0 < 2048; u0 += nb * 4) compress_unit(KCR, VCR, p, l, KC, VCT, u0 + q, (float*)(lds + q * 30720), qtid);
        }
        {
            FRESH_TID();
            const int half = tid >> 8, htid = tid & 255;
            for (int u0 = bid * 2; u0 < 512; u0 += nb * 2) gmlp_unit(H, p.gm_ln_g + l * 256, p.gm_ln_b + l * 256, p.gm_ws + (size_t)l * 4 * 128 * 128, p.gm_bs + l * 512, MIX, u0 + half, (float*)(lds + half * 32768), htid);
        }
        grid.sync();
        {
            FRESH_TID();
            for (int wg = bid * 8 + wave; wg < 2048; wg += nb * 8) {
                const int bg = wg & 3, c = wg >> 2;
#pragma unroll 1
                for (int k = 0; k < 4; ++k) { const int tq = (k == 0) ? c : (k == 1) ? 1023 - c : (k == 2) ? 1024 + c : 2047 - c; cmp_item(QN, KC, VCT, OC, SELM, bg, tq, lane, (float*)(lds + 40960 + wave * 2048)); }
            }
        }
        {
            FRESH_TID();
            DenseArgs a{}; a.Q = QN; a.qpitch = 512; a.K = KW; a.Vt = VWT; a.vpitch = SEQ; a.OWw = OW;
            for (int u = bid; u < 512; u += nb) dense_unit<0>(a, u, lds, tid);
        }
        {
            FRESH_TID();
            DenseArgs a{}; a.Q = MQ; a.qpitch = 256; a.K = MK + (size_t)l * 8 * 256 * 64; a.Vt = MVT + (size_t)l * 8 * 256 * 64; a.vpitch = 256; a.H = H; a.MIX = MIX;
            for (int u = bid; u < 256; u += nb) dense_unit<2>(a, u, lds, tid);
        }
        grid.sync();
        {
            FRESH_TID();
            DenseArgs a{}; a.Q = QN; a.qpitch = 512; a.K = KS; a.Vt = VST; a.vpitch = SEQ; a.H = H; a.OWr = OW; a.OCr = OC; a.MIX = MIX; a.SELM = SELM;
            for (int pr = bid; pr < 256; pr += nb) { const int bg = pr >> 6, pi = pr & 63; dense_unit<1>(a, bg * 128 + pi, lds, tid); dense_unit<1>(a, bg * 128 + 127 - pi, lds, tid); }
        }
        grid.sync();
        { FRESH_TID(); EpiArgs e{}; e.resid = (l == 0) ? p.x : p.out; e.out = p.out; gemm_phase<2>(MIX, WOUT + (size_t)l * 1024 * 1024, 1024, TOK / 128, 8, e, lds, bid, nb, tid); }
        grid.sync();
        { FRESH_TID(); for (int row = bid * 8 + wave; row < TOK; row += nb * 8) ln_row(p.out, p.ln_g + l * 1024, p.ln_b + l * 1024, (l == 0) ? XB : nullptr, row, lane); }
        if (l == 0) grid.sync();
    }
}

extern "C" void kernel_launch(void* const* d_in, const int* in_sizes, int n_in, void* d_out, int out_size, void* d_ws, size_t ws_size, hipStream_t stream) {
    static int grid_blocks = 0;
    if (grid_blocks == 0) {
        int dev = 0, cus = 0, per_cu = 0;
        hipGetDevice(&dev);
        hipDeviceGetAttribute(&cus, hipDeviceAttributeMultiprocessorCount, dev);
        hipFuncSetAttribute((const void*)mega, hipFuncAttributeMaxDynamicSharedMemorySize, LDS_BYTES);
        hipOccupancyMaxActiveBlocksPerMultiprocessor(&per_cu, (const void*)mega, NTHREADS, LDS_BYTES);
        if (per_cu < 1) { fprintf(stderr, "occupancy query says %d blocks/CU\n", per_cu); per_cu = 1; }
        if (per_cu > 1) per_cu = 1;
        grid_blocks = cus * per_cu;
    }
    if (ws_size < WS_END || n_in < 17) return;
    Params p{};
    p.x = (const float*)d_in[0]; p.mem = (const float*)d_in[1]; p.w_in = (const float*)d_in[2]; p.gm_ln_g = (const float*)d_in[3]; p.gm_ln_b = (const float*)d_in[4];
    p.gm_ws = (const float*)d_in[5]; p.gm_bs = (const float*)d_in[6]; p.cmp_pos_k = (const float*)d_in[7]; p.cmp_k_w1 = (const float*)d_in[8]; p.cmp_k_w2 = (const float*)d_in[9];
    p.cmp_pos_v = (const float*)d_in[10]; p.cmp_v_w1 = (const float*)d_in[11]; p.cmp_v_w2 = (const float*)d_in[12]; p.w_mem_kv = (const float*)d_in[13]; p.w_out = (const float*)d_in[14];
    p.ln_g = (const float*)d_in[15]; p.ln_b = (const float*)d_in[16]; p.out = (float*)d_out; p.ws = (char*)d_ws;
    void* args[] = {&p};
    hipError_t e = hipLaunchCooperativeKernel((const void*)mega, dim3(grid_blocks), dim3(NTHREADS), args, LDS_BYTES, stream);
    if (e != hipSuccess) fprintf(stderr, "cooperative launch failed: %s (grid %d)\n", hipGetErrorString(e), grid_blocks);
}
```
